# Optimizing an MI355X kernel written in HIP

```python
import math
import jax, jax.numpy as jnp
from jax import lax
import numpy as np

D_MODEL = 2048
BATCH = 8
SEQ = 4096
DEPTH = 4

MIX_WIDTH = D_MODEL
HEAD_DIM = 128
DIFF_WIDTH = MIX_WIDTH // 2
CONV_WIDTH = MIX_WIDTH // 4
MEM_WIDTH = MIX_WIDTH - DIFF_WIDTH - CONV_WIDTH
DIFF_HEADS = DIFF_WIDTH // HEAD_DIM
DIFF_QK_DIM = HEAD_DIM // 2
CONV_GROUPS = CONV_WIDTH // HEAD_DIM
CONV_TAPS = 3
MEM_HEADS = 4
MEM_HEAD_DIM = MEM_WIDTH // MEM_HEADS
MEM_TOKENS = 256
D_FF = 4 * D_MODEL
Q_BLOCK = 128
IN_WIDTH = 3 * DIFF_WIDTH + 3 * CONV_WIDTH + MEM_WIDTH
EPS = 1e-6

kernel_name = "hybrid_diffattn_shortconv_memxattn_encoder"


def rms_norm(x, g):
    xf = x.astype(jnp.float32)
    y = xf * lax.rsqrt(jnp.mean(xf * xf, axis=-1, keepdims=True) + EPS)
    return (y * g.astype(jnp.float32)).astype(x.dtype)


def alibi_slopes(n_heads):
    return jnp.asarray([2.0 ** (-8.0 * (i + 1) / n_heads) for i in range(n_heads)], dtype=jnp.float32)


def diff_attention(q, k, v, slopes, lam, lambda_init, g_sub):
    bsz, seq = q.shape[0], q.shape[1]
    n_blk = seq // Q_BLOCK
    scale = DIFF_QK_DIM ** -0.5
    q_blocks = q.reshape(bsz, n_blk, Q_BLOCK, DIFF_HEADS, 2, DIFF_QK_DIM).transpose(1, 0, 2, 3, 4, 5)
    starts = jnp.arange(n_blk, dtype=jnp.int32) * Q_BLOCK
    k_pos = jnp.arange(seq, dtype=jnp.float32)

    def one_block(args):
        q_blk, start = args
        q_pos = (start + jnp.arange(Q_BLOCK, dtype=jnp.int32)).astype(jnp.float32)
        dist = jnp.abs(q_pos[:, None] - k_pos[None, :])
        s = jnp.einsum('bqhcd,bkhcd->bhcqk', q_blk, k).astype(jnp.float32) * scale
        s = s - slopes[None, :, None, None, None] * dist[None, None, None]
        p = jax.nn.softmax(s, axis=-1)
        a = p[:, :, 0] - lam * p[:, :, 1]
        return jnp.einsum('bhqk,bkhd->bqhd', a.astype(v.dtype), v)

    o = lax.map(one_block, (q_blocks, starts))
    o = o.transpose(1, 0, 2, 3, 4).reshape(bsz, seq, DIFF_HEADS, 2 * DIFF_QK_DIM)
    o = rms_norm(o, g_sub) * (1.0 - lambda_init)
    return o.reshape(bsz, seq, DIFF_WIDTH)


def short_conv(u, w):
    return lax.conv_general_dilated(
        u, w[:, None, :].astype(u.dtype), window_strides=(1,), padding=[(1, 1)],
        dimension_numbers=('NWC', 'WIO', 'NWC'), feature_group_count=u.shape[-1])


def memory_attention(q, mem_n, w_kv, g_q, g_k):
    bsz, seq = q.shape[0], q.shape[1]
    kv = mem_n @ w_kv
    km, vm = jnp.split(kv, 2, axis=-1)
    km = rms_norm(km.reshape(bsz, -1, MEM_HEADS, MEM_HEAD_DIM), g_k)
    vm = vm.reshape(bsz, -1, MEM_HEADS, MEM_HEAD_DIM)
    qh = rms_norm(q.reshape(bsz, seq, MEM_HEADS, MEM_HEAD_DIM), g_q)
    s = jnp.einsum('bqhd,bmhd->bhqm', qh, km).astype(jnp.float32) * (MEM_HEAD_DIM ** -0.5)
    p = jax.nn.softmax(s, axis=-1)
    o = jnp.einsum('bhqm,bmhd->bqhd', p.astype(vm.dtype), vm)
    return o.reshape(bsz, seq, MEM_WIDTH)


def setup_inputs(seed: int = 0) -> dict:
    key = jax.random.key(seed)
    ks = jax.random.split(key, 24)
    f32 = jnp.float32

    def nrm(k, shape, std):
        return jax.random.normal(k, shape, dtype=f32) * std

    def gain(k, shape):
        return 1.0 + 0.02 * jax.random.normal(k, shape, dtype=f32)

    return {
        "x": nrm(ks[0], (BATCH, SEQ, D_MODEL), 1.0),
        "mem": nrm(ks[1], (BATCH, MEM_TOKENS, D_MODEL), 1.0),
        "g_mix": gain(ks[2], (DEPTH, D_MODEL)),
        "w_in": nrm(ks[3], (DEPTH, D_MODEL, IN_WIDTH), D_MODEL ** -0.5),
        "g_q_diff": gain(ks[4], (DEPTH, DIFF_QK_DIM)),
        "g_k_diff": gain(ks[5], (DEPTH, DIFF_QK_DIM)),
        "lam_q1": nrm(ks[6], (DEPTH, DIFF_QK_DIM), 0.1),
        "lam_k1": nrm(ks[7], (DEPTH, DIFF_QK_DIM), 0.1),
        "lam_q2": nrm(ks[8], (DEPTH, DIFF_QK_DIM), 0.1),
        "lam_k2": nrm(ks[9], (DEPTH, DIFF_QK_DIM), 0.1),
        "g_subln": gain(ks[10], (DEPTH, 2 * DIFF_QK_DIM)),
        "conv_w": nrm(ks[11], (DEPTH, CONV_TAPS, CONV_WIDTH), CONV_TAPS ** -0.5),
        "g_conv_out": gain(ks[12], (DEPTH, CONV_WIDTH)),
        "g_mem": gain(ks[13], (DEPTH, D_MODEL)),
        "w_mem_kv": nrm(ks[14], (DEPTH, D_MODEL, 2 * MEM_WIDTH), D_MODEL ** -0.5),
        "g_q_mem": gain(ks[15], (DEPTH, MEM_HEAD_DIM)),
        "g_k_mem": gain(ks[16], (DEPTH, MEM_HEAD_DIM)),
        "w_out": nrm(ks[17], (DEPTH, MIX_WIDTH, D_MODEL), MIX_WIDTH ** -0.5),
        "g_mlp": gain(ks[18], (DEPTH, D_MODEL)),
        "w_up": nrm(ks[19], (DEPTH, D_MODEL, D_FF), D_MODEL ** -0.5),
        "w_down": nrm(ks[20], (DEPTH, D_FF, D_MODEL), D_FF ** -0.5),
    }


def reference(x, mem, g_mix, w_in, g_q_diff, g_k_diff, lam_q1, lam_k1, lam_q2, lam_k2,
              g_subln, conv_w, g_conv_out, g_mem, w_mem_kv, g_q_mem, g_k_mem,
              w_out, g_mlp, w_up, w_down):
    bsz, seq = x.shape[0], x.shape[1]
    slopes = alibi_slopes(DIFF_HEADS)
    splits = [DIFF_WIDTH, 2 * DIFF_WIDTH, 3 * DIFF_WIDTH,
              3 * DIFF_WIDTH + CONV_WIDTH, 3 * DIFF_WIDTH + 2 * CONV_WIDTH,
              3 * DIFF_WIDTH + 3 * CONV_WIDTH]
    for l in range(DEPTH):
        h = rms_norm(x, g_mix[l])
        proj = h @ w_in[l]
        q_d, k_d, v_d, gate_b, gate_c, u, q_m = jnp.split(proj, splits, axis=-1)

        q_d = rms_norm(q_d.reshape(bsz, seq, DIFF_HEADS, 2, DIFF_QK_DIM), g_q_diff[l])
        k_d = rms_norm(k_d.reshape(bsz, seq, DIFF_HEADS, 2, DIFF_QK_DIM), g_k_diff[l])
        v_d = v_d.reshape(bsz, seq, DIFF_HEADS, 2 * DIFF_QK_DIM)
        lambda_init = 0.8 - 0.6 * math.exp(-0.3 * l)
        lam = (jnp.exp(jnp.sum(lam_q1[l].astype(jnp.float32) * lam_k1[l].astype(jnp.float32)))
               - jnp.exp(jnp.sum(lam_q2[l].astype(jnp.float32) * lam_k2[l].astype(jnp.float32)))
               + lambda_init)
        a_out = diff_attention(q_d, k_d, v_d, slopes, lam, lambda_init, g_subln[l])

        c_out = gate_b * short_conv(gate_c * u, conv_w[l])
        c_out = rms_norm(c_out.reshape(bsz, seq, CONV_GROUPS, HEAD_DIM),
                         g_conv_out[l].reshape(CONV_GROUPS, HEAD_DIM)).reshape(bsz, seq, CONV_WIDTH)

        mem_n = rms_norm(mem, g_mem[l])
        m_out = memory_attention(q_m, mem_n, w_mem_kv[l], g_q_mem[l], g_k_mem[l])

        mixed = jnp.concatenate([a_out, c_out, m_out], axis=-1)
        x = x + mixed @ w_out[l]

        h = rms_norm(x, g_mlp[l])
        x = x + jnp.square(jax.nn.relu(h @ w_up[l])) @ w_down[l]
    return x
```

```cpp
#include <hip/hip_runtime.h>
#include <cstdio>
#include <cstdint>

constexpr int BATCH = 8, SEQ = 4096, DM = 2048, DEPTH = 4;
constexpr int MTOT = BATCH * SEQ;
constexpr int NIN = 5120, DFF = 8192, NKV = 1024, MEMTOK = 256, MROWS = BATCH * MEMTOK;
constexpr float EPS = 1e-6f;
constexpr float LOG2E = 1.4426950408889634f;
constexpr float QSCALE_D = 0.125f * LOG2E;
constexpr float QSCALE_M = 0.08838834764831845f * LOG2E;
#ifndef NCH
#define NCH 2
#endif
constexpr int MCH = MTOT / NCH;

namespace pg8 {
#define PG8_LAS __attribute__((address_space(3)))
typedef unsigned short bf16_t;
typedef short bf16x8 __attribute__((ext_vector_type(8)));
typedef float f32x4 __attribute__((ext_vector_type(4)));
typedef unsigned u32x4 __attribute__((ext_vector_type(4)));
constexpr int BM = 256, BK = 64, HALF = 128, HTB = HALF * BK * 2  , STAGE_BYTES = 8 * HTB, NXCD = 8, WGM = 8;

__host__ __device__ __forceinline__ int lds_byte(int r, int c) { const int st = (r >> 4) * 2 + (c >> 5), rr = r & 15, cc = c & 31, ob = rr * 64 + cc * 2; return st * 1024 + (ob ^ (((ob >> 9) & 1) << 5)); }
__host__ __device__ __forceinline__ void stage_rc(int b, int& R, int& C) { const int st = b / 1024, sb = b % 1024, swz = sb ^ (((sb >> 9) & 1) << 5); R = (st >> 1) * 16 + swz / 64; C = (st & 1) * 32 + (swz % 64) / 2; }
__host__ __device__ __forceinline__ int perm32(int rho) { const int n = rho >> 4, i = rho & 15; return 8 * (i >> 2) + 4 * n + (i & 3); }

struct Unit { int pm, pn; };
struct Gemm { const bf16_t* A; const bf16_t* Bt; int M, N, K; };

struct StaticOrder {
    int nM, nN, nwg, G, c;
    __host__ __device__ void init(int M, int N, int G_, int c_) { nM = M / BM; nN = N / BM; nwg = nM * nN; G = G_; c = c_; }
    __host__ __device__ bool next(int i, Unit& u) const {
        const long L = (long)i * G + c; if (L >= nwg) return false;
        int wgid = (int)L; { const int q = nwg / NXCD, r = nwg % NXCD, xcd = wgid % NXCD, off = wgid / NXCD; wgid = (xcd < r ? xcd * (q + 1) : r * (q + 1) + (xcd - r) * q) + off; }
        const int nig = WGM * nN, gid = wgid / nig, fm = gid * WGM, gsz = (nM - fm) < WGM ? (nM - fm) : WGM;
        u.pm = fm + ((wgid % nig) % gsz); u.pn = (wgid % nig) / gsz; return true;
    }
    __device__ __forceinline__ void a_ready(const Unit&) const {}
    __device__ __forceinline__ void done(const Unit&) const {}
};

__device__ __forceinline__ unsigned cvt_pk_bf16(float lo, float hi) { unsigned r; asm volatile("v_cvt_pk_bf16_f32 %0, %1, %2" : "=v"(r) : "v"(lo), "v"(hi)); return r; }
template <class Epi, class Sched, bool ALIGN_EPI = false, bool SP2 = false>
__device__ __forceinline__ void gemm_phase(PG8_LAS unsigned char* lds, const Gemm g, const Sched& S, const Epi& E) {
    int tid_ = threadIdx.x; asm volatile("" : "+v"(tid_));
    const int tid = tid_, wid = __builtin_amdgcn_readfirstlane(tid >> 6), lane = tid & 63, wr = wid >> 2, wc = wid & 3, fr = lane & 15, fq = lane >> 4;
    const int K = g.K, nt = K / BK;
    unsigned voffA[2], voffB[2];
#pragma unroll
    for (int i = 0; i < 2; ++i) { int R, C; stage_rc(tid * 16 + i * 8192, R, C); const int Rb = Epi::PERM ? ((R & ~31) + perm32(R & 31)) : R;
        voffA[i] = (unsigned)(R * K + C) * 2u; voffB[i] = (unsigned)(Rb * K + C) * 2u; }
    const size_t kstep = (size_t)(BK * 2);
    const size_t hstep = (size_t)HALF * K * 2;
    const size_t tstep = 2 * hstep;
    const unsigned ldsw = (unsigned)wid * 1024u;
    const int aoff = lds_byte(wr * 64 + fr, fq * 8), boff = lds_byte(wc * 32 + fr, fq * 8);
#define PG8_SA(b, h) (((b) * 2 + (h)) * HTB)
#define PG8_SB(b, h) ((4 + (b) * 2 + (h)) * HTB)
#define PG8_STAGE(bufoff, gbase, voff) do { _Pragma("unroll") for (int _i = 0; _i < 2; ++_i) \
        __builtin_amdgcn_global_load_lds((const unsigned*)((const char*)(gbase) + (voff)[_i]), (PG8_LAS unsigned*)(lds + (bufoff) + ldsw + _i * 8192), 16, 0, 0); } while (0)
#define PG8_LDA(dst, b, h) do { _Pragma("unroll") for (int m = 0; m < 4; ++m) _Pragma("unroll") for (int k = 0; k < 2; ++k) dst[m][k] = *(const PG8_LAS bf16x8*)(lds + PG8_SA(b, h) + aoff + m * 2048 + k * 1024); } while (0)
#define PG8_LDB(dst, b, h) do { _Pragma("unroll") for (int n = 0; n < 2; ++n) _Pragma("unroll") for (int k = 0; k < 2; ++k) dst[n][k] = *(const PG8_LAS bf16x8*)(lds + PG8_SB(b, h) + boff + n * 2048 + k * 1024); } while (0)
#define PG8_MMA(ai, bj, At, Bt) do { __builtin_amdgcn_s_setprio(1); _Pragma("unroll") for (int m = 0; m < 4; ++m) _Pragma("unroll") for (int n = 0; n < 2; ++n) _Pragma("unroll") for (int k = 0; k < 2; ++k) \
        acc[ai][bj][m][n] = __builtin_amdgcn_mfma_f32_16x16x32_bf16(Bt[n][k], At[m][k], acc[ai][bj][m][n], 0, 0, 0); __builtin_amdgcn_s_setprio(0); } while (0)
#define PG8_WAIT_V(n) asm volatile("s_waitcnt vmcnt(" #n ")" ::: "memory")
#define PG8_WAIT_L(n) asm volatile("s_waitcnt lgkmcnt(" #n ")" ::: "memory")
#define PG8_BAR __builtin_amdgcn_s_barrier()
#define PG8_SCHED __builtin_amdgcn_sched_barrier(0)
    Unit cur, nxt; int ui = 0;
    if (!S.next(0, cur)) return;
    f32x4 acc[2][2][4][2];
#pragma unroll
    for (int a = 0; a < 2; ++a)
#pragma unroll
        for (int b = 0; b < 2; ++b)
#pragma unroll
            for (int m = 0; m < 4; ++m)
#pragma unroll
                for (int n = 0; n < 2; ++n) acc[a][b][m][n] = (f32x4){0.f, 0.f, 0.f, 0.f};
    bf16x8 At[4][2], B0[2][2], B1[2][2];
    const char* cA = (const char*)g.A + (size_t)cur.pm * tstep; const char* cB = (const char*)g.Bt + (size_t)cur.pn * tstep;
    S.a_ready(cur);
    if constexpr (SP2) {
        PG8_STAGE(PG8_SB(0, 0), cB, voffB); PG8_STAGE(PG8_SB(0, 1), cB + hstep, voffB); PG8_STAGE(PG8_SA(0, 0), cA, voffA); PG8_STAGE(PG8_SA(0, 1), cA + hstep, voffA);
        if (wr == 1) PG8_BAR;
        PG8_WAIT_V(2); PG8_BAR;
        PG8_STAGE(PG8_SB(1, 0), cB + kstep, voffB); PG8_STAGE(PG8_SA(1, 0), cA + kstep, voffA); PG8_STAGE(PG8_SB(1, 1), cB + hstep + kstep, voffB);
        PG8_WAIT_V(6); PG8_BAR;
    } else {
        PG8_STAGE(PG8_SB(0, 0), cB, voffB); PG8_STAGE(PG8_SA(0, 0), cA, voffA); PG8_STAGE(PG8_SB(0, 1), cB + hstep, voffB); PG8_STAGE(PG8_SA(0, 1), cA + hstep, voffA);
        if (wr == 1) PG8_BAR;
        PG8_WAIT_V(4); PG8_BAR;
        PG8_STAGE(PG8_SB(1, 0), cB + kstep, voffB); PG8_STAGE(PG8_SA(1, 0), cA + kstep, voffA); PG8_STAGE(PG8_SB(1, 1), cB + hstep + kstep, voffB);
        PG8_WAIT_V(6); PG8_BAR;
    }
    for (;;) {
        const bool has_next = S.next(ui + 1, nxt);
        const char* nA = has_next ? (const char*)g.A + (size_t)nxt.pm * tstep : cA; const char* nB = has_next ? (const char*)g.Bt + (size_t)nxt.pn * tstep : cB;
        for (int t = 0; t < nt; t += 2) {
            const bool last = (t == nt - 2);
            const char* a1 = cA + (size_t)(t + 1) * kstep;
            const char* a2 = last ? nA : cA + (size_t)(t + 2) * kstep; const char* b2 = last ? nB : cB + (size_t)(t + 2) * kstep;
            const char* a3 = a2 + kstep; const char* b3 = b2 + kstep;
            if (last && has_next) S.a_ready(nxt);
            if constexpr (SP2) {
            PG8_LDB(B0, 0, 0); PG8_LDB(B1, 0, 1); PG8_SCHED; PG8_LDA(At, 0, 0); PG8_STAGE(PG8_SA(1, 1), a1 + hstep, voffA);
            PG8_WAIT_V(8); PG8_WAIT_L(0); PG8_BAR; PG8_MMA(0, 0, At, B0); PG8_MMA(0, 1, At, B1); PG8_BAR; PG8_SCHED;
            PG8_LDA(At, 0, 1); PG8_STAGE(PG8_SB(0, 0), b2, voffB); PG8_STAGE(PG8_SB(0, 1), b2 + hstep, voffB); PG8_STAGE(PG8_SA(0, 0), a2, voffA);
            PG8_WAIT_V(8); PG8_WAIT_L(0); PG8_BAR; PG8_MMA(1, 0, At, B0); PG8_MMA(1, 1, At, B1); PG8_BAR; PG8_SCHED;
            PG8_LDB(B0, 1, 0); PG8_LDB(B1, 1, 1); PG8_SCHED; PG8_LDA(At, 1, 0); PG8_STAGE(PG8_SA(0, 1), a2 + hstep, voffA);
            PG8_WAIT_V(8); PG8_WAIT_L(0); PG8_BAR; PG8_MMA(0, 0, At, B0); PG8_MMA(0, 1, At, B1); PG8_BAR; PG8_SCHED;
            PG8_LDA(At, 1, 1); PG8_STAGE(PG8_SB(1, 0), b3, voffB); PG8_STAGE(PG8_SB(1, 1), b3 + hstep, voffB); PG8_STAGE(PG8_SA(1, 0), a3, voffA);
            PG8_WAIT_V(8); PG8_WAIT_L(0); PG8_BAR; PG8_MMA(1, 0, At, B0); PG8_MMA(1, 1, At, B1); PG8_BAR; PG8_SCHED;
            } else {
            PG8_LDB(B0, 0, 0); PG8_SCHED; PG8_LDA(At, 0, 0); PG8_STAGE(PG8_SA(1, 1), a1 + hstep, voffA);
            PG8_WAIT_L(8); PG8_BAR; PG8_WAIT_L(0); PG8_MMA(0, 0, At, B0); PG8_BAR; PG8_SCHED;
            PG8_LDB(B1, 0, 1); PG8_STAGE(PG8_SB(0, 0), b2, voffB);
            PG8_BAR; PG8_WAIT_L(0); PG8_MMA(0, 1, At, B1); PG8_BAR;
            PG8_LDA(At, 0, 1); PG8_STAGE(PG8_SA(0, 0), a2, voffA);
            PG8_BAR; PG8_WAIT_L(0); PG8_MMA(1, 0, At, B0); PG8_BAR; PG8_SCHED;
            PG8_STAGE(PG8_SB(0, 1), b2 + hstep, voffB);
            PG8_WAIT_V(6); PG8_BAR; PG8_MMA(1, 1, At, B1); PG8_BAR;
            PG8_LDB(B0, 1, 0); PG8_SCHED; PG8_LDA(At, 1, 0); PG8_STAGE(PG8_SA(0, 1), a2 + hstep, voffA);
            PG8_WAIT_L(8); PG8_BAR; PG8_WAIT_L(0); PG8_MMA(0, 0, At, B0); PG8_BAR; PG8_SCHED;
            PG8_LDB(B1, 1, 1); PG8_STAGE(PG8_SB(1, 0), b3, voffB);
            PG8_BAR; PG8_WAIT_L(0); PG8_MMA(0, 1, At, B1); PG8_BAR;
            PG8_LDA(At, 1, 1); PG8_STAGE(PG8_SA(1, 0), a3, voffA);
            PG8_BAR; PG8_WAIT_L(0); PG8_MMA(1, 0, At, B0); PG8_BAR; PG8_SCHED;
            PG8_STAGE(PG8_SB(1, 1), b3 + hstep, voffB);
            PG8_WAIT_V(6); PG8_BAR; PG8_MMA(1, 1, At, B1); PG8_BAR;
            }
        }
        if constexpr (ALIGN_EPI) { if (wr == 0) PG8_BAR; }
        if constexpr (!Epi::AFTER_DRAIN) { E(acc, cur, wr, wc, fr, fq); S.done(cur); }
        if (!has_next) break;
#pragma unroll
        for (int a = 0; a < 2; ++a)
#pragma unroll
            for (int b = 0; b < 2; ++b)
#pragma unroll
                for (int m = 0; m < 4; ++m)
#pragma unroll
                    for (int n = 0; n < 2; ++n) acc[a][b][m][n] = (f32x4){0.f, 0.f, 0.f, 0.f};
        cur = nxt; cA = nA; cB = nB; ++ui;
        if constexpr (ALIGN_EPI) { if (wr == 1) PG8_BAR; }
    }
    PG8_WAIT_V(0);
    if constexpr (!ALIGN_EPI) { if (wr == 0) PG8_BAR; }
    PG8_BAR;
    if constexpr (Epi::AFTER_DRAIN) { E.fused(acc, cur, wr, wc, fr, fq, lds, wid, lane); S.done(cur); }
#undef PG8_SA
#undef PG8_SB
#undef PG8_STAGE
#undef PG8_LDA
#undef PG8_LDB
#undef PG8_MMA
#undef PG8_WAIT_V
#undef PG8_WAIT_L
#undef PG8_BAR
#undef PG8_SCHED
}
}

namespace pg8 {
typedef unsigned u32x2 __attribute__((ext_vector_type(2)));
__host__ __device__ __forceinline__ int slot_col(int s) { return 64 * ((s >> 5) & 3) + 16 * ((s >> 2) & 3) + 8 * (s >> 7) + 4 * ((s >> 4) & 1) + (s & 3); }

__device__ __forceinline__ void load_rstd(const float* __restrict__ rowss, int grow0, float (&rs)[2][4], int lane, int fr) {
#pragma unroll
    for (int ai = 0; ai < 2; ++ai) {
        const float* p = rowss + grow0 + 128 * ai + lane; float s = 0.f;
#pragma unroll
        for (int t = 0; t < 8; ++t) s += p[(size_t)t * MTOT];
        const float r = rsqrtf(s * (1.0f / DM) + EPS);
#pragma unroll
        for (int m = 0; m < 4; ++m) rs[ai][m] = __shfl(r, 16 * m + fr);
    }
}
__device__ __forceinline__ void store_bf16_16(bf16_t* dst, const float (&v)[16]) {
    u32x4 w0, w1;
    w0.x = cvt_pk_bf16(v[0], v[1]); w0.y = cvt_pk_bf16(v[2], v[3]); w0.z = cvt_pk_bf16(v[4], v[5]); w0.w = cvt_pk_bf16(v[6], v[7]);
    w1.x = cvt_pk_bf16(v[8], v[9]); w1.y = cvt_pk_bf16(v[10], v[11]); w1.z = cvt_pk_bf16(v[12], v[13]); w1.w = cvt_pk_bf16(v[14], v[15]);
    *(u32x4*)dst = w0; *(u32x4*)(dst + 8) = w1;
}

struct EpiA {
    static constexpr bool PERM = false, AFTER_DRAIN = false;
    bf16_t* P; const float* rowss; const float* gq; const float* gk;
    __device__ __forceinline__ void operator()(const f32x4 (&acc)[2][2][4][2], const Unit& u, int wr, int wc, int fr, int fq) const {
        const int lane = fr + 16 * fq; const int rbase = u.pm * BM + wr * 64;
        float rs[2][4]; load_rstd(rowss, rbase, rs, lane, fr);
        const int col0 = u.pn * BM + wc * 64 + 16 * fq;
        const int mode = u.pn < 4 ? 1 : (u.pn < 8 ? 2 : 0);
        float g[16];
        if (mode) { const float* gp = (mode == 1 ? gq : gk) + 16 * fq; const float sc = (mode == 1) ? QSCALE_D : 1.0f;
#pragma unroll
            for (int i = 0; i < 16; ++i) g[i] = gp[i] * sc; }
        else {
#pragma unroll
            for (int i = 0; i < 16; ++i) g[i] = 1.f; }
#pragma unroll
        for (int ai = 0; ai < 2; ++ai)
#pragma unroll
            for (int m = 0; m < 4; ++m) {
                float v[16]; const float r = rs[ai][m];
#pragma unroll
                for (int bj = 0; bj < 2; ++bj)
#pragma unroll
                    for (int n = 0; n < 2; ++n)
#pragma unroll
                        for (int e = 0; e < 4; ++e) v[8 * bj + 4 * n + e] = acc[ai][bj][m][n][e] * r;
                if (mode) {
                    float ss = 0.f;
#pragma unroll
                    for (int i = 0; i < 16; ++i) ss += v[i] * v[i];
                    ss += __shfl_xor(ss, 16); ss += __shfl_xor(ss, 32);
                    const float rn = rsqrtf(ss * (1.0f / 64.0f) + EPS);
#pragma unroll
                    for (int i = 0; i < 16; ++i) v[i] = v[i] * rn * g[i];
                }
                store_bf16_16(P + (size_t)(rbase + ai * HALF + m * 16 + fr) * NIN + col0, v);
                asm volatile("" ::: "memory");
            }
    }
};
struct EpiRelu2 {
    static constexpr bool PERM = false, AFTER_DRAIN = false;
    bf16_t* H; const float* rowss; int m0;
    __device__ __forceinline__ void operator()(const f32x4 (&acc)[2][2][4][2], const Unit& u, int wr, int wc, int fr, int fq) const {
        const int lane = fr + 16 * fq; const int rbase = u.pm * BM + wr * 64;
        float rs[2][4]; load_rstd(rowss, m0 + rbase, rs, lane, fr);
        const int col0 = u.pn * BM + wc * 64 + 16 * fq;
#pragma unroll
        for (int ai = 0; ai < 2; ++ai)
#pragma unroll
            for (int m = 0; m < 4; ++m) {
                float v[16]; const float r = rs[ai][m];
#pragma unroll
                for (int bj = 0; bj < 2; ++bj)
#pragma unroll
                    for (int n = 0; n < 2; ++n)
#pragma unroll
                        for (int e = 0; e < 4; ++e) { const float t = fmaxf(acc[ai][bj][m][n][e] * r, 0.f); v[8 * bj + 4 * n + e] = t * t; }
                store_bf16_16(H + (size_t)(rbase + ai * HALF + m * 16 + fr) * DFF + col0, v);
                asm volatile("" ::: "memory");
            }
    }
};
struct EpiRes {
    static constexpr bool PERM = false, AFTER_DRAIN = false;
    const float* xold; float* xnew; bf16_t* XB; float* rowss; int m0; PG8_LAS float* scr;
    __device__ __forceinline__ void operator()(const f32x4 (&acc)[2][2][4][2], const Unit& u, int wr, int wc, int fr, int fq) const {
        const int rbase = m0 + u.pm * BM + wr * 64; const int col0 = u.pn * BM + wc * 64 + 16 * fq;
#pragma unroll
        for (int ai = 0; ai < 2; ++ai)
#pragma unroll
            for (int m = 0; m < 4; ++m) {
                const size_t off = (size_t)(rbase + ai * HALF + m * 16 + fr) * DM + col0;
                f32x4 o[4];
#pragma unroll
                for (int q = 0; q < 4; ++q) o[q] = *(const f32x4*)(xold + off + 4 * q);
                float v[16]; float ss = 0.f;
#pragma unroll
                for (int bj = 0; bj < 2; ++bj)
#pragma unroll
                    for (int n = 0; n < 2; ++n) { const f32x4 t = acc[ai][bj][m][n] + o[2 * bj + n]; *(f32x4*)(xnew + off + 8 * bj + 4 * n) = t;
#pragma unroll
                        for (int e = 0; e < 4; ++e) { v[8 * bj + 4 * n + e] = t[e]; ss += t[e] * t[e]; } }
                store_bf16_16(XB + off, v);
                ss += __shfl_xor(ss, 16); ss += __shfl_xor(ss, 32);
                if (fq == 0) scr[wc * 256 + ai * HALF + wr * 64 + m * 16 + fr] = ss;
                asm volatile("" ::: "memory");
            }
        asm volatile("s_waitcnt lgkmcnt(0)" ::: "memory"); __builtin_amdgcn_s_barrier(); asm volatile("" ::: "memory");
        int tid = threadIdx.x; asm volatile("" : "+v"(tid));
        if (tid < 256) rowss[(size_t)u.pn * MTOT + m0 + u.pm * BM + tid] = (scr[tid] + scr[256 + tid]) + (scr[512 + tid] + scr[768 + tid]);
    }
};
struct EpiF32 {
    static constexpr bool PERM = false, AFTER_DRAIN = false;
    float* O; int ldc;
    __device__ __forceinline__ void operator()(const f32x4 (&acc)[2][2][4][2], const Unit& u, int wr, int wc, int fr, int fq) const {
        const int rbase = u.pm * BM + wr * 64; const int col0 = u.pn * BM + wc * 64 + 16 * fq;
#pragma unroll
        for (int ai = 0; ai < 2; ++ai)
#pragma unroll
            for (int m = 0; m < 4; ++m) { float* rowp = O + (size_t)(rbase + ai * HALF + m * 16 + fr) * ldc + col0;
#pragma unroll
                for (int bj = 0; bj < 2; ++bj)
#pragma unroll
                    for (int n = 0; n < 2; ++n) *(f32x4*)(rowp + 8 * bj + 4 * n) = acc[ai][bj][m][n]; }
    }
};
}

#define GAS __attribute__((address_space(1)))
#define LAS __attribute__((address_space(3)))
typedef unsigned short bf16;
typedef unsigned v4u __attribute__((ext_vector_type(4)));
typedef float f32x4 __attribute__((ext_vector_type(4)));
typedef short bf16x8 __attribute__((ext_vector_type(8)));
typedef GAS unsigned gu32;
typedef GAS unsigned long long gu64;
#define RLX_AGENT __ATOMIC_RELAXED, __HIP_MEMORY_SCOPE_AGENT
#define LDS_WAIT() asm volatile("s_waitcnt lgkmcnt(0)" ::: "memory")
#define VM_WAIT() asm volatile("s_waitcnt vmcnt(0)" ::: "memory")
__device__ __forceinline__ unsigned long long rt() { return __builtin_amdgcn_s_memrealtime(); }
__device__ __forceinline__ unsigned f2bf(float f) { unsigned u = __builtin_bit_cast(unsigned, f); return (u + 0x7fffu + ((u >> 16) & 1u)) >> 16; }
__device__ __forceinline__ unsigned pk2(float lo, float hi) { return f2bf(lo) | (f2bf(hi) << 16); }

#define XB_TMO      128
#define XB_XCNT(j)  (256  + 64 * (j))
#define XB_XSUB(j)  (1280 + 64 * (j))
#define XB_XGEN(j)  (2304 + 64 * (j))
#define XB_TOP      3328
#define XB_TOPGEN   3392
#define XCD_BAR_WORDS 3456
#define XB_SPIN_CAP (1u << 18)

__device__ __forceinline__ unsigned xb_ld(unsigned* p)              { return __hip_atomic_load(p, __ATOMIC_RELAXED, __HIP_MEMORY_SCOPE_AGENT); }
__device__ __forceinline__ unsigned xb_add(unsigned* p, unsigned v) { return __hip_atomic_fetch_add(p, v, __ATOMIC_RELAXED, __HIP_MEMORY_SCOPE_AGENT); }
__device__ __forceinline__ unsigned xb_xcc_id() { return (unsigned)__builtin_amdgcn_s_getreg((3 << 11) | 20) & 0xFu; }
#define XB_SPIN(cond, bar) do { unsigned _sp = 0; while (cond) { __builtin_amdgcn_s_sleep(1); \
    if ((++_sp & 255u) == 0u) { if (xb_ld(&(bar)[XB_TMO])) break; if (_sp > XB_SPIN_CAP) { atomicAdd(&(bar)[XB_TMO], 1u); break; } } } } while (0)

struct XcdBarrier {
    unsigned* bar; unsigned x;
    volatile LAS unsigned* st;
};

__device__ __forceinline__ XcdBarrier xcd_barrier_post(unsigned* bar, volatile LAS unsigned* st) {
    XcdBarrier b; b.bar = bar; b.x = xb_xcc_id(); b.st = st;
    if (threadIdx.x == 0) (void)xb_add(&bar[XB_XCNT(b.x)], 1u);
    return b;
}
__device__ __forceinline__ void xcd_barrier_complete(unsigned* bar, unsigned x, unsigned& nloc, unsigned& nx) {
    const unsigned G = gridDim.x * gridDim.y * gridDim.z;
    unsigned sum, cnt, mine, sp = 0u;
    for (;;) {
        sum = 0u; cnt = 0u; mine = 0u;
#pragma unroll
        for (unsigned j = 0; j < 16; ++j) { const unsigned c = xb_ld(&bar[XB_XCNT(j)]); sum += c; cnt += (c > 0u) ? 1u : 0u; mine = (j == x) ? c : mine; }
        if (sum == G) break;
        __builtin_amdgcn_s_sleep(1);
        if ((++sp & 255u) == 0u) { if (xb_ld(&bar[XB_TMO])) break; if (sp > XB_SPIN_CAP) { atomicAdd(&bar[XB_TMO], 1u); break; } }
    }
    nloc = mine > 0u ? mine : 1u; nx = cnt > 0u ? cnt : 1u;
}

__device__ __forceinline__ void xcd_barrier(const XcdBarrier& b) {
    asm volatile("s_waitcnt vmcnt(0)" ::: "memory");
    __syncthreads();
    if (threadIdx.x == 0) {
        GAS unsigned* barg = (GAS unsigned*)b.bar; asm volatile("" : "+s"(barg)); unsigned* bar = (unsigned*)barg;
        __builtin_amdgcn_s_waitcnt(0);
        unsigned nloc = b.st[0], nx = b.st[1];
        if (nloc == 0u) { xcd_barrier_complete(bar, b.x, nloc, nx); b.st[0] = nloc; b.st[1] = nx; }
        const unsigned old = xb_add(&bar[XB_XSUB(b.x)], 1u);
        const unsigned gen = old / nloc;
        if (old + 1u == (gen + 1u) * nloc) {
            __builtin_amdgcn_fence(__ATOMIC_RELEASE, "agent");
            asm volatile("s_waitcnt vmcnt(0)" ::: "memory");
            const unsigned og = xb_add(&bar[XB_TOP], 1u);
            const unsigned tg = og / nx;
            if (og + 1u == (tg + 1u) * nx) xb_add(&bar[XB_TOPGEN], 1u);
            else XB_SPIN(xb_ld(&bar[XB_TOPGEN]) == tg, bar);
            __builtin_amdgcn_fence(__ATOMIC_ACQUIRE, "agent");
            xb_add(&bar[XB_XGEN(b.x)], 1u);
            asm volatile("s_waitcnt vmcnt(0)" ::: "memory");
        } else {
            XB_SPIN(xb_ld(&bar[XB_XGEN(b.x)]) == gen, bar);
            __builtin_amdgcn_fence(__ATOMIC_ACQUIRE, "agent");
            asm volatile("s_waitcnt vmcnt(0)" ::: "memory");
        }
    }
    __syncthreads();
}


__device__ __forceinline__ float wave_sum(float v) {
#pragma unroll
    for (int o = 1; o < 64; o <<= 1) v += __shfl_xor(v, o);
    return v;
}
__device__ __forceinline__ float bf2f(short s) { return __uint_as_float(((unsigned)(unsigned short)s) << 16); }
__device__ __forceinline__ bf16x8 pack8(const float (&f)[8]) {
    v4u w; w.x = pg8::cvt_pk_bf16(f[0], f[1]); w.y = pg8::cvt_pk_bf16(f[2], f[3]); w.z = pg8::cvt_pk_bf16(f[4], f[5]); w.w = pg8::cvt_pk_bf16(f[6], f[7]);
    return __builtin_bit_cast(bf16x8, w);
}

namespace att {
using s16x4  = __attribute__((ext_vector_type(4))) short;
using f32x16 = __attribute__((ext_vector_type(16))) float;
constexpr int KVBLK = 64;
constexpr int SHM_V = KVBLK * 128 * 2, SHM_K = KVBLK * 128 * 2;
constexpr int OFF_V = 0, OFF_K = 2 * SHM_V, OFF_WS = 2 * SHM_V + 2 * SHM_K, OFF_X = OFF_WS + 8 * 64 * 4, ATT_LDS = OFF_X + 4 * 4096 * 4;
constexpr float THR2 = 8.f * LOG2E;
#define KSWZ(row, colB) ((row) * 256 + ((colB) ^ (((row) & 7) << 4)))
#define SBAR() __builtin_amdgcn_sched_barrier(0)
__device__ __forceinline__ int crow(int r, int hi) { return (r & 3) + 8 * (r >> 2) + 4 * hi; }

template <bool BIAS>
__device__ __forceinline__ void partialSM(f32x16& p0, f32x16& p1, float& m_reg, float& mn, float& alpha, float nmh2, float dq) {
  if constexpr (BIAS) {
#pragma unroll
    for (int r = 0; r < 16; ++r) { const float c = (float)((r & 3) + 8 * (r >> 2));
      p0[r] = fmaf(nmh2, fabsf(dq - c), p0[r]); p1[r] = fmaf(nmh2, fabsf(dq - (c + 32.f)), p1[r]); }
  }
  float pmax = p0[0];
#pragma unroll
  for (int r = 1; r < 16; ++r) pmax = fmaxf(pmax, p0[r]);
#pragma unroll
  for (int r = 0; r < 16; ++r) pmax = fmaxf(pmax, p1[r]);
  { auto rr = __builtin_amdgcn_permlane32_swap(__float_as_uint(pmax), __float_as_uint(pmax), false, false);
    pmax = fmaxf(__uint_as_float(rr[0]), __uint_as_float(rr[1])); }
  if (__builtin_expect(__all(pmax - m_reg <= THR2), 1)) { mn = m_reg; alpha = 1.f; }
  else { mn = fmaxf(m_reg, pmax); alpha = __builtin_amdgcn_exp2f(m_reg - mn); m_reg = mn; }
#pragma unroll
  for (int r = 0; r < 16; ++r) { p0[r] = p0[r] - mn; p1[r] = p1[r] - mn; }
#pragma unroll
  for (int r = 0; r < 16; ++r) p0[r] = __builtin_amdgcn_exp2f(p0[r]);
}
__device__ __forceinline__ void finishSM(f32x16& p0, f32x16& p1, float alpha, float& l_reg, bf16x8& pa0, bf16x8& pa1, bf16x8& pa2, bf16x8& pa3) {
#pragma unroll
  for (int r = 0; r < 16; ++r) p1[r] = __builtin_amdgcn_exp2f(p1[r]);
  float ps = 0;
#pragma unroll
  for (int r = 0; r < 16; ++r) ps += p0[r];
#pragma unroll
  for (int r = 0; r < 16; ++r) ps += p1[r];
  { auto rr = __builtin_amdgcn_permlane32_swap(__float_as_uint(ps), __float_as_uint(ps), false, false);
    ps = __uint_as_float(rr[0]) + __uint_as_float(rr[1]); }
  l_reg = l_reg * alpha + ps;
#define PK4(P, BASE, OUT) do { unsigned a0 = pg8::cvt_pk_bf16(P[BASE + 0], P[BASE + 1]), a1 = pg8::cvt_pk_bf16(P[BASE + 2], P[BASE + 3]);   \
    unsigned b0 = pg8::cvt_pk_bf16(P[BASE + 4], P[BASE + 5]), b1 = pg8::cvt_pk_bf16(P[BASE + 6], P[BASE + 7]);                              \
    auto r0 = __builtin_amdgcn_permlane32_swap(a0, b0, false, false); auto r1 = __builtin_amdgcn_permlane32_swap(a1, b1, false, false); \
    v4u w = {r0[0], r1[0], r0[1], r1[1]}; OUT = __builtin_bit_cast(bf16x8, w); } while (0)
  PK4(p0, 0, pa0); PK4(p0, 8, pa1); PK4(p1, 0, pa2); PK4(p1, 8, pa3);
#undef PK4
}
template <int ND0>
__device__ __forceinline__ void qkt(f32x16& p0, f32x16& p1, LAS const char* Ks, const bf16x8* qr, int r32, int hi, int dcol0) {
  p0 = f32x16{}; p1 = f32x16{};
#pragma unroll
  for (int d0 = 0; d0 < ND0; ++d0) { const int cb = (dcol0 + d0 * 16 + hi * 8) * 2;
    const bf16x8 b0 = *(LAS const bf16x8*)(Ks + KSWZ(r32, cb));
    const bf16x8 b1 = *(LAS const bf16x8*)(Ks + KSWZ(32 + r32, cb));
    p0 = __builtin_amdgcn_mfma_f32_32x32x16_bf16(b0, qr[d0], p0, 0, 0, 0);
    p1 = __builtin_amdgcn_mfma_f32_32x32x16_bf16(b1, qr[d0], p1, 0, 0, 0); }
}
__device__ __forceinline__ int v_st(int k, int c) { const int kk = (k & ~0xC) | ((k & 4) << 1) | ((k & 8) >> 1); return ((kk >> 3) * 4 + (c >> 5)) * 512 + ((kk & 7) * 32 + (c & 31)) * 2; }
__device__ __forceinline__ int v_rd_base(int lane) { return ((lane & 3) << 3) | (((lane >> 2) & 3) << 6) | (((lane >> 4) & 1) << 5) | (((lane >> 5) & 1) << 8); }
constexpr int v_rd_off(int d0, int ks, int half) { return d0 * 512 + ks * 4096 + half * 2048; }
template <int OFF> __device__ __forceinline__ s16x4 tr_read(int vb) {
  s16x4 r; asm volatile("ds_read_b64_tr_b16 %0, %1 offset:%2" : "=&v"(r) : "v"(vb), "i"(OFF) : "memory"); return r;
}
template <int D0> __device__ __forceinline__ void pv_one(f32x16& od, int vb, bf16x8 pa0, bf16x8 pa1, bf16x8 pa2, bf16x8 pa3) {
  const s16x4 l0 = tr_read<v_rd_off(D0, 0, 0)>(vb), h0 = tr_read<v_rd_off(D0, 0, 1)>(vb), l1 = tr_read<v_rd_off(D0, 1, 0)>(vb), h1 = tr_read<v_rd_off(D0, 1, 1)>(vb);
  const s16x4 l2 = tr_read<v_rd_off(D0, 2, 0)>(vb), h2 = tr_read<v_rd_off(D0, 2, 1)>(vb), l3 = tr_read<v_rd_off(D0, 3, 0)>(vb), h3 = tr_read<v_rd_off(D0, 3, 1)>(vb);
  asm volatile("s_waitcnt lgkmcnt(0)" ::: "memory"); SBAR();
#define PK(L, H) (bf16x8){L[0], L[1], L[2], L[3], H[0], H[1], H[2], H[3]}
  od = __builtin_amdgcn_mfma_f32_32x32x16_bf16(pa0, PK(l0, h0), od, 0, 0, 0);
  od = __builtin_amdgcn_mfma_f32_32x32x16_bf16(pa1, PK(l1, h1), od, 0, 0, 0);
  od = __builtin_amdgcn_mfma_f32_32x32x16_bf16(pa2, PK(l2, h2), od, 0, 0, 0);
  od = __builtin_amdgcn_mfma_f32_32x32x16_bf16(pa3, PK(l3, h3), od, 0, 0, 0);
#undef PK
}
__device__ __forceinline__ void pv_d0(f32x16* o, int vb, bf16x8 pa0, bf16x8 pa1, bf16x8 pa2, bf16x8 pa3) {
  pv_one<0>(o[0], vb, pa0, pa1, pa2, pa3); pv_one<1>(o[1], vb, pa0, pa1, pa2, pa3); pv_one<2>(o[2], vb, pa0, pa1, pa2, pa3); pv_one<3>(o[3], vb, pa0, pa1, pa2, pa3);
}

template <int MODE>
__device__ __forceinline__ void attn_unit(LAS char* lds, const bf16* __restrict__ Qb, int ldq, const bf16* __restrict__ Kh, const bf16* __restrict__ Vh, int ldk,
                                          int NT, int jd, float nmh2, int qpos0, bf16* __restrict__ Ob, int ldo, const float* __restrict__ gvec, float lam, float osc) {
  constexpr int ND0 = MODE == 0 ? 4 : 8;
  int tid_ = threadIdx.x; asm volatile("" : "+v"(tid_));
  const int tid = tid_, wid = __builtin_amdgcn_readfirstlane(tid >> 6), lane = tid & 63, r32 = lane & 31, hi = lane >> 5;
  const int map = MODE == 0 ? (wid >> 2) : 0, wq = MODE == 0 ? (wid & 3) : wid;
  LAS float* wsf = (LAS float*)(lds + OFF_WS) + wid * 64; LAS float* li_l = wsf; LAS float* al_l = wsf + 32;
  float m_reg = -1e30f, l_reg = 0; f32x16 o[4] = {}; bf16x8 qr[ND0];
  const bf16* Qw = Qb + (size_t)(wq * 32 + r32) * ldq + map * 64 + hi * 8;
  if constexpr (MODE == 0) {
#pragma unroll
    for (int d0 = 0; d0 < ND0; ++d0) qr[d0] = *(const bf16x8*)(Qw + d0 * 16);
  } else {
    float ss = 0.f;
#pragma unroll
    for (int d0 = 0; d0 < ND0; ++d0) { qr[d0] = *(const bf16x8*)(Qw + d0 * 16);
#pragma unroll
      for (int i = 0; i < 8; ++i) { const float f = bf2f(qr[d0][i]); ss += f * f; } }
    ss += __shfl_xor(ss, 32);
    const float rn = rsqrtf(ss * (1.0f / 128.0f) + EPS) * QSCALE_M;
#pragma unroll
    for (int d0 = 0; d0 < ND0; ++d0) { float f[8];
#pragma unroll
      for (int i = 0; i < 8; ++i) f[i] = bf2f(qr[d0][i]) * rn * gvec[d0 * 16 + hi * 8 + i];
      qr[d0] = pack8(f); }
  }
  const int sr = tid >> 4, sc = (tid & 15) * 8, vst0 = v_st(sr, sc), vst1 = v_st(32 + sr, sc);
  const int vb0 = (int)(uintptr_t)(lds + OFF_V) + v_rd_base(lane);
  const float dqbase = (float)(qpos0 + wq * 32 + r32 - 4 * hi);
  struct { bf16x8 vs0, vs1, ks0, ks1; } sr_[2];
#define TILE_K0(i) ((((jd) + (i)) & (NT - 1)) * KVBLK)
#define DQ(i) (dqbase - (float)TILE_K0(i))
#define SLOAD(s, i) do { const int k0_ = TILE_K0(i); sr_[s].vs0 = *(const bf16x8*)(Vh + (size_t)(k0_ + sr) * ldk + sc); sr_[s].vs1 = *(const bf16x8*)(Vh + (size_t)(k0_ + 32 + sr) * ldk + sc); \
    sr_[s].ks0 = *(const bf16x8*)(Kh + (size_t)(k0_ + sr) * ldk + sc); sr_[s].ks1 = *(const bf16x8*)(Kh + (size_t)(k0_ + 32 + sr) * ldk + sc); } while (0)
#define SWRITE(b, s) do { *(LAS bf16x8*)(lds + OFF_V + (b) * SHM_V + vst0) = sr_[s].vs0; *(LAS bf16x8*)(lds + OFF_V + (b) * SHM_V + vst1) = sr_[s].vs1; const int kc = sc * 2; \
    *(LAS bf16x8*)(lds + OFF_K + (b) * SHM_K + KSWZ(sr, kc)) = sr_[s].ks0; *(LAS bf16x8*)(lds + OFF_K + (b) * SHM_K + KSWZ(32 + sr, kc)) = sr_[s].ks1; } while (0)
#define SWAIT() asm volatile("s_waitcnt vmcnt(4)" ::: "memory")
#define RESC(a) do { if (__any((a) < 1.f)) { if (hi == 0) al_l[r32] = (a); asm volatile("s_waitcnt lgkmcnt(0)" ::: "memory"); \
    _Pragma("unroll") for (int d = 0; d < 4; ++d) _Pragma("unroll") for (int r = 0; r < 16; ++r) o[d][r] *= al_l[crow(r, hi)]; } } while (0)
  f32x16 pA0, pA1, pB0, pB1; float mnA, mnB, alA, alB; bf16x8 pa0, pa1, pa2, pa3;
  LAS const char* K0 = lds + OFF_K; LAS const char* K1 = lds + OFF_K + SHM_K;
  __syncthreads();
  SLOAD(0, 0); asm volatile("s_waitcnt vmcnt(0)" ::: "memory"); SWRITE(0, 0); __syncthreads();
  qkt<ND0>(pA0, pA1, K0, qr, r32, hi, map * 64); partialSM<MODE == 0>(pA0, pA1, m_reg, mnA, alA, nmh2, DQ(0));
  SLOAD(1, 1); if (2 < NT) SLOAD(0, 2);
  SWAIT(); SWRITE(1, 1); __syncthreads();
  for (int j = 1; j + 1 < NT; j += 2) {
    SBAR(); qkt<ND0>(pB0, pB1, K1, qr, r32, hi, map * 64);
    finishSM(pA0, pA1, alA, l_reg, pa0, pa1, pa2, pa3); SBAR();
    SLOAD(1, j + 2); SBAR();
    pv_d0(o, vb0, pa0, pa1, pa2, pa3); partialSM<MODE == 0>(pB0, pB1, m_reg, mnB, alB, nmh2, DQ(j));
    __syncthreads(); SWAIT(); SWRITE(0, 0);
    RESC(alB); __syncthreads();
    SBAR(); qkt<ND0>(pA0, pA1, K0, qr, r32, hi, map * 64);
    finishSM(pB0, pB1, alB, l_reg, pa0, pa1, pa2, pa3); SBAR();
    if (j + 3 < NT) SLOAD(0, j + 3); SBAR();
    pv_d0(o, vb0 + SHM_V, pa0, pa1, pa2, pa3); partialSM<MODE == 0>(pA0, pA1, m_reg, mnA, alA, nmh2, DQ(j + 1));
    __syncthreads(); SWAIT(); SWRITE(1, 1);
    RESC(alA); __syncthreads();
  }
  SBAR(); qkt<ND0>(pB0, pB1, K1, qr, r32, hi, map * 64);
  finishSM(pA0, pA1, alA, l_reg, pa0, pa1, pa2, pa3); SBAR();
  pv_d0(o, vb0, pa0, pa1, pa2, pa3); partialSM<MODE == 0>(pB0, pB1, m_reg, mnB, alB, nmh2, DQ(NT - 1));
  __syncthreads(); RESC(alB);
  finishSM(pB0, pB1, alB, l_reg, pa0, pa1, pa2, pa3); SBAR();
  pv_d0(o, vb0 + SHM_V, pa0, pa1, pa2, pa3);
  if (hi == 0) li_l[r32] = l_reg;
  asm volatile("s_waitcnt lgkmcnt(0)" ::: "memory");
  float rli[16];
#pragma unroll
  for (int r = 0; r < 16; ++r) rli[r] = __builtin_amdgcn_rcpf(li_l[crow(r, hi)]);
  bf16* Ow = Ob + (size_t)(wq * 32) * ldo;
  if constexpr (MODE == 1) {
#pragma unroll
    for (int r = 0; r < 16; ++r) { const int orow = crow(r, hi);
#pragma unroll
      for (int d0 = 0; d0 < 4; ++d0) Ow[(size_t)orow * ldo + d0 * 32 + r32] = (bf16)f2bf(o[d0][r] * rli[r]); }
  } else {
    LAS float* X = (LAS float*)(lds + OFF_X) + wq * 4096;
    if (map == 1) {
#pragma unroll
      for (int d0 = 0; d0 < 4; ++d0)
#pragma unroll
        for (int r = 0; r < 16; ++r) X[(d0 * 16 + r) * 64 + lane] = o[d0][r] * rli[r] * lam;
    }
    asm volatile("s_waitcnt lgkmcnt(0)" ::: "memory");
    __syncthreads();
    if (map == 0) {
      float ss[16];
#pragma unroll
      for (int r = 0; r < 16; ++r) ss[r] = 0.f;
#pragma unroll
      for (int d0 = 0; d0 < 4; ++d0)
#pragma unroll
        for (int r = 0; r < 16; ++r) { const float d = o[d0][r] * rli[r] - X[(d0 * 16 + r) * 64 + lane]; o[d0][r] = d; ss[r] += d * d; }
#pragma unroll
      for (int r = 0; r < 16; ++r) {
#pragma unroll
        for (int s = 1; s < 32; s <<= 1) ss[r] += __shfl_xor(ss[r], s);
        ss[r] = rsqrtf(ss[r] * (1.0f / 128.0f) + EPS) * osc; }
      float g[4];
#pragma unroll
      for (int d0 = 0; d0 < 4; ++d0) g[d0] = gvec[d0 * 32 + r32];
#pragma unroll
      for (int r = 0; r < 16; ++r) { const int orow = crow(r, hi);
#pragma unroll
        for (int d0 = 0; d0 < 4; ++d0) Ow[(size_t)orow * ldo + d0 * 32 + r32] = (bf16)f2bf(o[d0][r] * ss[r] * g[d0]); }
    }
  }
#undef TILE_K0
#undef DQ
#undef SLOAD
#undef SWRITE
#undef SWAIT
#undef RESC
}
}

constexpr size_t MiB = 1u << 20;
constexpr size_t WS_CTL = 0, CTL_ZERO_BYTES = 1 * MiB;
constexpr size_t WS_ROWSS = 1 * MiB;
constexpr size_t WS_KVB = 4 * MiB;
constexpr size_t WS_WIN = 20 * MiB;
constexpr size_t WS_WKV = 100 * MiB;
constexpr size_t WS_WOUT = 116 * MiB;
constexpr size_t WS_WUP = 148 * MiB;
constexpr size_t WS_WDN = 276 * MiB;
constexpr size_t WS_XB = 404 * MiB;
constexpr size_t WS_MIX = 532 * MiB;
constexpr size_t WS_KVRAW = WS_MIX;
constexpr size_t WS_MEMB = WS_MIX + 32 * MiB;
constexpr size_t WS_PROJ = 660 * MiB;
constexpr size_t WS_HID = WS_PROJ;
constexpr size_t WS_END = 980 * MiB;
static_assert((size_t)MCH * DFF * 2 <= 320 * MiB, "hidden chunk fits the PROJ region");
constexpr int CW_BAR = 4096;
constexpr int LDS_BYTES = 163840;
constexpr int LDS_SCR = 131072;
constexpr int LDS_MISC = LDS_BYTES - 512;
constexpr int LDS_PTRS = LDS_BYTES - 256;
static_assert(att::ATT_LDS <= LDS_MISC && LDS_SCR + 4096 <= LDS_MISC && 64 * 516 * 4 <= LDS_MISC, "LDS map");

__device__ __forceinline__ void cvt_w_tile(const float* __restrict__ W, int K, int N, const float* __restrict__ g, bf16* __restrict__ WT, int kb, int nb, LAS float* scr, int tid) {
    const int k0 = kb * 64, n0 = nb * 512;
#pragma unroll 4
    for (int it = 0; it < 16; ++it) { const int kk = it * 4 + (tid >> 7), c4 = (tid & 127) * 4;
        f32x4 w = *(const GAS f32x4*)(W + (size_t)(k0 + kk) * N + n0 + c4);
        const float gg = g ? g[k0 + kk] : 1.f; w = w * gg;
        *(LAS f32x4*)(scr + kk * 516 + c4) = w; }
    __syncthreads();
    const int s = tid & 255, pl = tid >> 8, col = pl * 256 + pg8::slot_col(s);
    bf16* dst = WT + (size_t)(n0 + pl * 256 + s) * K + k0;
#pragma unroll
    for (int c = 0; c < 8; ++c) { float f[8];
#pragma unroll
        for (int j = 0; j < 8; ++j) f[j] = scr[(8 * c + j) * 516 + col];
        *(GAS bf16x8*)(dst + 8 * c) = pack8(f); }
    __syncthreads();
}
__device__ __forceinline__ float row_to_bf16(const float* __restrict__ xrow, bf16* __restrict__ orow, bool normalise, int lane) {
    const GAS f32x4* xr = (const GAS f32x4*)xrow + lane;
    f32x4 v[8]; float s = 0.f;
#pragma unroll
    for (int j = 0; j < 8; ++j) { v[j] = xr[64 * j]; s += (v[j].x * v[j].x + v[j].y * v[j].y) + (v[j].z * v[j].z + v[j].w * v[j].w); }
    s = wave_sum(s);
    const float sc = normalise ? rsqrtf(s * (1.0f / DM) + EPS) : 1.f;
    GAS unsigned long long* o8 = (GAS unsigned long long*)orow + lane;
#pragma unroll
    for (int j = 0; j < 8; ++j) o8[64 * j] = (unsigned long long)pg8::cvt_pk_bf16(v[j].x * sc, v[j].y * sc) | ((unsigned long long)pg8::cvt_pk_bf16(v[j].z * sc, v[j].w * sc) << 32);
    return s;
}
__device__ __forceinline__ void kv_row(const float* __restrict__ src, bf16* __restrict__ dst, const float* __restrict__ gk, int lane) {
    const f32x4 a = *(const GAS f32x4*)(src + 8 * lane), b = *(const GAS f32x4*)(src + 8 * lane + 4);
    float ss = (a.x * a.x + a.y * a.y) + (a.z * a.z + a.w * a.w) + (b.x * b.x + b.y * b.y) + (b.z * b.z + b.w * b.w);
    ss += __shfl_xor(ss, 1); ss += __shfl_xor(ss, 2); ss += __shfl_xor(ss, 4); ss += __shfl_xor(ss, 8);
    const float rn = rsqrtf(ss * (1.0f / 128.0f) + EPS);
    const float* gp = gk + ((8 * lane) & 127);
    float f[8] = {a.x * rn * gp[0], a.y * rn * gp[1], a.z * rn * gp[2], a.w * rn * gp[3], b.x * rn * gp[4], b.y * rn * gp[5], b.z * rn * gp[6], b.w * rn * gp[7]};
    *(GAS bf16x8*)(dst + 8 * lane) = pack8(f);
    const f32x4 c = *(const GAS f32x4*)(src + 512 + 8 * lane), d = *(const GAS f32x4*)(src + 512 + 8 * lane + 4);
    float h[8] = {c.x, c.y, c.z, c.w, d.x, d.y, d.z, d.w};
    *(GAS bf16x8*)(dst + 512 + 8 * lane) = pack8(h);
}
__device__ __forceinline__ void load_gcu(const bf16* __restrict__ P, int row, int c0, float (&v)[8]) {
    const bf16x8 gc = *(const GAS bf16x8*)(P + (size_t)row * NIN + 3584 + c0), uu = *(const GAS bf16x8*)(P + (size_t)row * NIN + 4096 + c0);
#pragma unroll
    for (int i = 0; i < 8; ++i) v[i] = bf2f(gc[i]) * bf2f(uu[i]);
}
__device__ __forceinline__ void conv_rows16(const bf16* __restrict__ P, bf16* __restrict__ MIX, const float* __restrict__ cw, const float* __restrict__ gco, int row0, int lane) {
    const int c0 = lane * 8;
    float w0[8], w1[8], w2[8], g[8];
#pragma unroll
    for (int i = 0; i < 8; ++i) { w0[i] = cw[c0 + i]; w1[i] = cw[512 + c0 + i]; w2[i] = cw[1024 + c0 + i]; g[i] = gco[c0 + i]; }
    float vp[8], vc[8], vn[8];
    if ((row0 & (SEQ - 1)) != 0) load_gcu(P, row0 - 1, c0, vp); else {
#pragma unroll
        for (int i = 0; i < 8; ++i) vp[i] = 0.f; }
    load_gcu(P, row0, c0, vc);
    for (int r = 0; r < 16; ++r) { const int row = row0 + r;
        if ((row & (SEQ - 1)) != SEQ - 1) load_gcu(P, row + 1, c0, vn); else {
#pragma unroll
            for (int i = 0; i < 8; ++i) vn[i] = 0.f; }
        const bf16x8 gb = *(const GAS bf16x8*)(P + (size_t)row * NIN + 3072 + c0);
        float c[8]; float ss = 0.f;
#pragma unroll
        for (int i = 0; i < 8; ++i) { const float y = w0[i] * vp[i] + w1[i] * vc[i] + w2[i] * vn[i]; c[i] = bf2f(gb[i]) * y; ss += c[i] * c[i]; }
        ss += __shfl_xor(ss, 1); ss += __shfl_xor(ss, 2); ss += __shfl_xor(ss, 4); ss += __shfl_xor(ss, 8);
        const float rn = rsqrtf(ss * (1.0f / 128.0f) + EPS);
#pragma unroll
        for (int i = 0; i < 8; ++i) { c[i] = c[i] * rn * g[i]; vp[i] = vc[i]; vc[i] = vn[i]; }
        *(GAS bf16x8*)(MIX + (size_t)row * DM + 1024 + c0) = pack8(c);
    }
}

template <class T> __device__ __forceinline__ GAS T* opq(T* p) { GAS T* q = (GAS T*)p; asm volatile("" : "+s"(q)); return q; }
__device__ __forceinline__ const float* in_ptr(LAS unsigned char* lds, int i) {
    unsigned off = LDS_PTRS + 8 * i; asm volatile("" : "+v"(off));
    const unsigned lo = *(volatile LAS unsigned*)(lds + off), hi = *(volatile LAS unsigned*)(lds + off + 4);
    return (const float*)(const GAS float*)(uintptr_t)(((unsigned long long)(unsigned)__builtin_amdgcn_readfirstlane((int)hi) << 32) | (unsigned)__builtin_amdgcn_readfirstlane((int)lo));
}
struct Args { const float* in[21]; float* out; unsigned char* ws; int ph_lo, ph_hi; };
constexpr int PH_PER_LAYER = 3 + 2 * NCH, N_PHASES = 2 + DEPTH * PH_PER_LAYER;

__global__ void __launch_bounds__(512, 2) hybrid_fwd(Args args) {
    extern __shared__ __attribute__((aligned(16))) unsigned char lds_raw[];
    LAS unsigned char* lds = (LAS unsigned char*)lds_raw;
    volatile LAS unsigned* MISC = (volatile LAS unsigned*)(lds + LDS_MISC);
    const int tid0 = threadIdx.x, wave = __builtin_amdgcn_readfirstlane(tid0 >> 6);
    const int G = gridDim.x; const int bx = blockIdx.x; const int vcu = (G % 8 == 0) ? (bx % 8) * (G / 8) + bx / 8 : bx;
    unsigned char* ws0 = args.ws;
    if (tid0 < 64) MISC[tid0] = 0u;
    if (tid0 == 0) { LAS unsigned long long* pt = (LAS unsigned long long*)(lds + LDS_PTRS);
#define PUT(i) pt[i] = (unsigned long long)(uintptr_t)args.in[i]
        PUT(0); PUT(1); PUT(2); PUT(3); PUT(4); PUT(5); PUT(6); PUT(7); PUT(8); PUT(9); PUT(10); PUT(11); PUT(12); PUT(13); PUT(14); PUT(15); PUT(16); PUT(17); PUT(18); PUT(19); PUT(20);
#undef PUT
    }
    __syncthreads();
    XcdBarrier bar = xcd_barrier_post((unsigned*)(ws0 + WS_CTL) + CW_BAR, MISC + 8);
    float* out0 = args.out;
#define INP(i) in_ptr(lds, (i))
#define rowss ((float*)(GAS float*)(ws + WS_ROWSS))
#define KVB ((bf16*)(GAS bf16*)(ws + WS_KVB))
#define WIN ((bf16*)(GAS bf16*)(ws + WS_WIN))
#define WKV ((bf16*)(GAS bf16*)(ws + WS_WKV))
#define WOUT ((bf16*)(GAS bf16*)(ws + WS_WOUT))
#define WUP ((bf16*)(GAS bf16*)(ws + WS_WUP))
#define WDN ((bf16*)(GAS bf16*)(ws + WS_WDN))
#define XB ((bf16*)(GAS bf16*)(ws + WS_XB))
#define MIX ((bf16*)(GAS bf16*)(ws + WS_MIX))
#define KVRAW ((float*)(GAS float*)(ws + WS_KVRAW))
#define MEMB ((bf16*)(GAS bf16*)(ws + WS_MEMB))
#define PROJ ((bf16*)(GAS bf16*)(ws + WS_PROJ))
#define HID ((bf16*)(GAS bf16*)(ws + WS_HID))
    const int lo = args.ph_lo, hi = args.ph_hi;
#define IN(k) (lo <= (k) && (k) < hi)
#define SEAM(k) do { if (IN((k) + 1)) xcd_barrier(bar); } while (0)
    const int gw = vcu * 8 + wave, NGW = G * 8;

    if (IN(0)) {
            GAS unsigned char* ws = opq(ws0); float* out = (float*)opq(out0); (void)out; int tid = tid0; asm volatile("" : "+v"(tid)); const int lane = tid & 63; (void)lane;
        LAS float* scr = (LAS float*)lds;
        constexpr int T_IN = 32 * 10, T_KV = 32 * 2, T_OUT = 32 * 4, T_UP = 32 * 16, T_DN = 128 * 4, T_LAYER = T_IN + T_KV + T_OUT + T_UP + T_DN;
        for (int t = vcu; t < DEPTH * T_LAYER; t += G) {
            const int l = t / T_LAYER; int r = t % T_LAYER;
            if (r < T_IN) { cvt_w_tile(INP(3) + (size_t)l * DM * NIN, DM, NIN, INP(2) + l * DM, WIN + (size_t)l * NIN * DM, r / 10, r % 10, scr, tid); continue; } r -= T_IN;
            if (r < T_KV) { cvt_w_tile(INP(14) + (size_t)l * DM * NKV, DM, NKV, INP(13) + l * DM, WKV + (size_t)l * NKV * DM, r / 2, r % 2, scr, tid); continue; } r -= T_KV;
            if (r < T_OUT) { cvt_w_tile(INP(17) + (size_t)l * DM * DM, DM, DM, nullptr, WOUT + (size_t)l * DM * DM, r / 4, r % 4, scr, tid); continue; } r -= T_OUT;
            if (r < T_UP) { cvt_w_tile(INP(19) + (size_t)l * DM * DFF, DM, DFF, INP(18) + l * DM, WUP + (size_t)l * DFF * DM, r / 16, r % 16, scr, tid); continue; } r -= T_UP;
            cvt_w_tile(INP(20) + (size_t)l * DFF * DM, DFF, DM, nullptr, WDN + (size_t)l * DM * DFF, r / 4, r % 4, scr, tid);
        }
        for (int m = gw; m < MTOT; m += NGW) {
            const float s = row_to_bf16(INP(0) + (size_t)m * DM, XB + (size_t)m * DM, false, lane);
            if (lane < 8) rowss[(size_t)lane * MTOT + m] = lane == 0 ? s : 0.f;
        }
        for (int m = gw; m < MROWS; m += NGW) (void)row_to_bf16(INP(1) + (size_t)m * DM, MEMB + (size_t)m * DM, true, lane);
        SEAM(0);
    }
    if (IN(1)) {
            GAS unsigned char* ws = opq(ws0); float* out = (float*)opq(out0); (void)out; int tid = tid0; asm volatile("" : "+v"(tid)); const int lane = tid & 63; (void)lane;
        pg8::Gemm g{MEMB, WKV, MROWS, DEPTH * NKV, DM}; pg8::StaticOrder S; S.init(MROWS, DEPTH * NKV, G, bx);
        pg8::EpiF32 E{KVRAW, DEPTH * NKV};
        pg8::gemm_phase<pg8::EpiF32, pg8::StaticOrder, true, true>(lds, g, S, E);
        SEAM(1);
    }
    for (int l = 0; l < DEPTH; ++l) {
        const int pb = 2 + l * PH_PER_LAYER;
        if (IN(pb)) {
            GAS unsigned char* ws = opq(ws0); float* out = (float*)opq(out0); (void)out; int tid = tid0; asm volatile("" : "+v"(tid)); const int lane = tid & 63; (void)lane;
            if (l == 0) {
                for (int it = gw; it < DEPTH * MROWS; it += NGW) { const int ll = it / MROWS, row = it % MROWS;
                    kv_row(KVRAW + (size_t)row * (DEPTH * NKV) + ll * NKV, KVB + ((size_t)ll * MROWS + row) * NKV, INP(16) + ll * 128, lane); }
            }
            pg8::Gemm g{XB, WIN + (size_t)l * NIN * DM, MTOT, NIN, DM}; pg8::StaticOrder S; S.init(MTOT, NIN, G, bx);
            pg8::EpiA E{PROJ, rowss, INP(4) + l * 64, INP(5) + l * 64};
            pg8::gemm_phase<pg8::EpiA, pg8::StaticOrder, true, true>(lds, g, S, E);
            SEAM(pb);
        }
        if (IN(pb + 1)) {
            GAS unsigned char* ws = opq(ws0); float* out = (float*)opq(out0); (void)out; int tid = tid0; asm volatile("" : "+v"(tid)); const int lane = tid & 63; (void)lane;
            float lam, osc;
            { float a = INP(6)[l * 64 + lane] * INP(7)[l * 64 + lane], b = INP(8)[l * 64 + lane] * INP(9)[l * 64 + lane];
              a = wave_sum(a); b = wave_sum(b); const float li = 0.8f - 0.6f * expf(-0.3f * (float)l); lam = expf(a) - expf(b) + li; osc = 1.f - li;
              lam = __uint_as_float(__builtin_amdgcn_readfirstlane(__float_as_uint(lam))); osc = __uint_as_float(__builtin_amdgcn_readfirstlane(__float_as_uint(osc))); }
            for (int ch = gw; ch < MTOT / 16; ch += NGW) conv_rows16(PROJ, MIX, INP(11) + l * 1536, INP(12) + l * 512, ch * 16, lane);
            for (int k = vcu; k < BATCH * 4 * (SEQ / 256); k += G) { const int bhm = k >> 4, qt = k & 15, b = bhm >> 2, hm = bhm & 3;
                const size_t r0 = (size_t)b * SEQ + qt * 256; const bf16* kv = KVB + ((size_t)l * MROWS + b * MEMTOK) * NKV + hm * 128;
                att::attn_unit<1>((LAS char*)lds, PROJ + r0 * NIN + 4608 + hm * 128, NIN, kv, kv + 512, NKV, MEMTOK / 64, 0, 0.f, 0,
                                  MIX + r0 * DM + 1536 + hm * 128, DM, INP(15) + l * 128, 0.f, 1.f); }
            for (int k = vcu; k < BATCH * 8 * (SEQ / 128); k += G) { const int bh = k >> 5, qt = k & 31, b = bh >> 3, h = bh & 7;
                const size_t r0 = (size_t)b * SEQ + qt * 128; const bf16* kb = PROJ + (size_t)b * SEQ * NIN + 1024 + h * 128;
                const float nmh2 = -exp2f(-(float)(h + 1)) * LOG2E;
                att::attn_unit<0>((LAS char*)lds, PROJ + r0 * NIN + h * 128, NIN, kb, kb + 1024, NIN, SEQ / 64, qt * 2, nmh2, qt * 128,
                                  MIX + r0 * DM + h * 128, DM, INP(10) + l * 128, lam, osc); }
            SEAM(pb + 1);
        }
        if (IN(pb + 2)) {
            GAS unsigned char* ws = opq(ws0); float* out = (float*)opq(out0); (void)out; int tid = tid0; asm volatile("" : "+v"(tid)); const int lane = tid & 63; (void)lane;
            pg8::Gemm g{MIX, WOUT + (size_t)l * DM * DM, MTOT, DM, DM}; pg8::StaticOrder S; S.init(MTOT, DM, G, bx);
            pg8::EpiRes E{l == 0 ? INP(0) : (const float*)out, out, XB, rowss, 0, (LAS float*)(lds + LDS_SCR)};
            pg8::gemm_phase<pg8::EpiRes, pg8::StaticOrder, true, true>(lds, g, S, E);
            SEAM(pb + 2);
        }
        for (int c = 0; c < NCH; ++c) {
            const int m0 = c * MCH;
            if (IN(pb + 3 + 2 * c)) {
            GAS unsigned char* ws = opq(ws0); float* out = (float*)opq(out0); (void)out; int tid = tid0; asm volatile("" : "+v"(tid)); const int lane = tid & 63; (void)lane;
                pg8::Gemm g{XB + (size_t)m0 * DM, WUP + (size_t)l * DFF * DM, MCH, DFF, DM}; pg8::StaticOrder S; S.init(MCH, DFF, G, bx);
                pg8::EpiRelu2 E{HID, rowss, m0};
                pg8::gemm_phase<pg8::EpiRelu2, pg8::StaticOrder, true, true>(lds, g, S, E);
                SEAM(pb + 3 + 2 * c);
            }
            if (IN(pb + 4 + 2 * c)) {
            GAS unsigned char* ws = opq(ws0); float* out = (float*)opq(out0); (void)out; int tid = tid0; asm volatile("" : "+v"(tid)); const int lane = tid & 63; (void)lane;
                pg8::Gemm g{HID, WDN + (size_t)l * DM * DFF, MCH, DM, DFF}; pg8::StaticOrder S; S.init(MCH, DM, G, bx);
                pg8::EpiRes E{(const float*)out, out, XB, rowss, m0, (LAS float*)(lds + LDS_SCR)};
                pg8::gemm_phase<pg8::EpiRes, pg8::StaticOrder, true, true>(lds, g, S, E);
                SEAM(pb + 4 + 2 * c);
            }
        }
    }
#undef IN
#undef SEAM
#undef INP
#undef rowss
#undef KVB
#undef WIN
#undef WKV
#undef WOUT
#undef WUP
#undef WDN
#undef XB
#undef MIX
#undef KVRAW
#undef MEMB
#undef PROJ
#undef HID
}

#ifndef N_LAUNCHES
#define N_LAUNCHES 1
#endif
extern "C" void kernel_launch(void* const* d_in, const int* in_sizes, int n_in, void* d_out, int out_size, void* d_ws, size_t ws_size, hipStream_t stream) {
    static int grid = 0;
    if (grid == 0) {
        if (n_in != 21 || in_sizes[0] != MTOT * DM || out_size != MTOT * DM || ws_size < WS_END) {
            fprintf(stderr, "kernel_launch: shape/workspace mismatch: n_in %d in0 %d out %d ws %zu (need %zu)\n", n_in, n_in > 0 ? in_sizes[0] : -1, out_size, ws_size, (size_t)WS_END); grid = -1; return; }
        int dev = 0, cus = 0, per_cu = 0;
        if (hipGetDevice(&dev) != hipSuccess || hipDeviceGetAttribute(&cus, hipDeviceAttributeMultiprocessorCount, dev) != hipSuccess) { grid = -1; return; }
        if (hipFuncSetAttribute((const void*)hybrid_fwd, hipFuncAttributeMaxDynamicSharedMemorySize, LDS_BYTES) != hipSuccess) { fprintf(stderr, "kernel_launch: hipFuncSetAttribute failed\n"); grid = -1; return; }
        if (hipOccupancyMaxActiveBlocksPerMultiprocessor(&per_cu, (const void*)hybrid_fwd, 512, LDS_BYTES) != hipSuccess || per_cu < 1)
            fprintf(stderr, "kernel_launch: note: occupancy query reports %d workgroups per CU\n", per_cu);
        (void)hipGetLastError();
        grid = cus;
    }
    if (grid < 0) return;
    Args a{};
    for (int i = 0; i < 21; ++i) a.in[i] = (const float*)d_in[i];
    a.out = (float*)d_out; a.ws = (unsigned char*)d_ws;
#if N_LAUNCHES == 1
    if (hipMemsetAsync((char*)d_ws + WS_CTL, 0, CTL_ZERO_BYTES, stream) != hipSuccess) return;
    a.ph_lo = 0; a.ph_hi = N_PHASES;
    hipLaunchKernelGGL(hybrid_fwd, dim3(grid), dim3(512), LDS_BYTES, stream, a);
#else
    for (int p = 0; p < N_PHASES; ++p) {
        if (hipMemsetAsync((char*)d_ws + WS_CTL, 0, CTL_ZERO_BYTES, stream) != hipSuccess) return;
        a.ph_lo = p; a.ph_hi = p + 1;
        hipLaunchKernelGGL(hybrid_fwd, dim3(grid), dim3(512), LDS_BYTES, stream, a);
    }
#endif
    const hipError_t le = hipPeekAtLastError();
    if (le != hipSuccess) fprintf(stderr, "kernel_launch: launch failed: %s\n", hipGetErrorName(le));
}
```

```cpp
#include <hip/hip_runtime.h>
#include <cstdio>
#include <cstdint>

constexpr int BATCH = 8, SEQ = 4096, DM = 2048, DEPTH = 4;
constexpr int MTOT = BATCH * SEQ;
constexpr int NIN = 5120, DFF = 8192, NKV = 1024, MEMTOK = 256, MROWS = BATCH * MEMTOK;
constexpr float EPS = 1e-6f;
constexpr float LOG2E = 1.4426950408889634f;
constexpr float QSCALE_D = 0.125f * LOG2E;
constexpr float QSCALE_M = 0.08838834764831845f * LOG2E;
#ifndef NCH
#define NCH 4
#endif
constexpr int MCH = MTOT / NCH;

namespace pg8 {
#define PG8_LAS __attribute__((address_space(3)))
typedef unsigned short bf16_t;
typedef short bf16x8 __attribute__((ext_vector_type(8)));
typedef float f32x4 __attribute__((ext_vector_type(4)));
typedef unsigned u32x4 __attribute__((ext_vector_type(4)));
constexpr int BM = 256, BK = 64, HALF = 128, HTB = HALF * BK * 2  , STAGE_BYTES = 8 * HTB, NXCD = 8, WGM = 8;

__host__ __device__ __forceinline__ int lds_byte(int r, int c) { const int st = (r >> 4) * 2 + (c >> 5), rr = r & 15, cc = c & 31, ob = rr * 64 + cc * 2; return st * 1024 + (ob ^ (((ob >> 9) & 1) << 5)); }
__host__ __device__ __forceinline__ void stage_rc(int b, int& R, int& C) { const int st = b / 1024, sb = b % 1024, swz = sb ^ (((sb >> 9) & 1) << 5); R = (st >> 1) * 16 + swz / 64; C = (st & 1) * 32 + (swz % 64) / 2; }
__host__ __device__ __forceinline__ int perm32(int rho) { const int n = rho >> 4, i = rho & 15; return 8 * (i >> 2) + 4 * n + (i & 3); }

struct Unit { int pm, pn; };
struct Gemm { const bf16_t* A; const bf16_t* Bt; int M, N, K; };

struct StaticOrder {
    int nM, nN, nwg, G, c;
    __host__ __device__ void init(int M, int N, int G_, int c_) { nM = M / BM; nN = N / BM; nwg = nM * nN; G = G_; c = c_; }
    __host__ __device__ bool next(int i, Unit& u) const {
        const long L = (long)i * G + c; if (L >= nwg) return false;
        int wgid = (int)L; { const int q = nwg / NXCD, r = nwg % NXCD, xcd = wgid % NXCD, off = wgid / NXCD; wgid = (xcd < r ? xcd * (q + 1) : r * (q + 1) + (xcd - r) * q) + off; }
        const int nig = WGM * nN, gid = wgid / nig, fm = gid * WGM, gsz = (nM - fm) < WGM ? (nM - fm) : WGM;
        u.pm = fm + ((wgid % nig) % gsz); u.pn = (wgid % nig) / gsz; return true;
    }
    __device__ __forceinline__ void a_ready(const Unit&) const {}
    __device__ __forceinline__ void done(const Unit&) const {}
};

typedef __bf16 bf16x2_t __attribute__((ext_vector_type(2)));
typedef float f32x2_t __attribute__((ext_vector_type(2)));
__device__ __forceinline__ unsigned cvt_pk_bf16(float lo, float hi) { const f32x2_t v = {lo, hi}; return __builtin_bit_cast(unsigned, __builtin_convertvector(v, bf16x2_t)); }
template <class Epi, class Sched, bool ALIGN_EPI = false, bool SP2 = false>
__device__ __forceinline__ void gemm_phase(PG8_LAS unsigned char* lds, const Gemm g, const Sched& S, const Epi& E) {
    int tid_ = threadIdx.x; asm volatile("" : "+v"(tid_));
    const int tid = tid_, wid = __builtin_amdgcn_readfirstlane(tid >> 6), lane = tid & 63, wr = wid >> 2, wc = wid & 3, fr = lane & 15, fq = lane >> 4;
    const int K = g.K, nt = K / BK;
    unsigned voffA[2], voffB[2];
#pragma unroll
    for (int i = 0; i < 2; ++i) { int R, C; stage_rc(tid * 16 + i * 8192, R, C); const int Rb = Epi::PERM ? ((R & ~31) + perm32(R & 31)) : R;
        voffA[i] = (unsigned)(R * K + C) * 2u; voffB[i] = (unsigned)(Rb * K + C) * 2u; }
    const size_t kstep = (size_t)(BK * 2);
    const size_t hstep = (size_t)HALF * K * 2;
    const size_t tstep = 2 * hstep;
    const unsigned ldsw = (unsigned)wid * 1024u;
    const int aoff = lds_byte(wr * 64 + fr, fq * 8), boff = lds_byte(wc * 32 + fr, fq * 8);
#define PG8_SA(b, h) (((b) * 2 + (h)) * HTB)
#define PG8_SB(b, h) ((4 + (b) * 2 + (h)) * HTB)
#define PG8_STAGE(bufoff, gbase, voff) do { _Pragma("unroll") for (int _i = 0; _i < 2; ++_i) \
        __builtin_amdgcn_global_load_lds((const unsigned*)((const char*)(gbase) + (voff)[_i]), (PG8_LAS unsigned*)(lds + (bufoff) + ldsw + _i * 8192), 16, 0, 0); } while (0)
#define PG8_LDA(dst, b, h) do { _Pragma("unroll") for (int m = 0; m < 4; ++m) _Pragma("unroll") for (int k = 0; k < 2; ++k) dst[m][k] = *(const PG8_LAS bf16x8*)(lds + PG8_SA(b, h) + aoff + m * 2048 + k * 1024); } while (0)
#define PG8_LDB(dst, b, h) do { _Pragma("unroll") for (int n = 0; n < 2; ++n) _Pragma("unroll") for (int k = 0; k < 2; ++k) dst[n][k] = *(const PG8_LAS bf16x8*)(lds + PG8_SB(b, h) + boff + n * 2048 + k * 1024); } while (0)
#define PG8_MMA(ai, bj, At, Bt) do { __builtin_amdgcn_s_setprio(1); _Pragma("unroll") for (int m = 0; m < 4; ++m) _Pragma("unroll") for (int n = 0; n < 2; ++n) _Pragma("unroll") for (int k = 0; k < 2; ++k) \
        acc[ai][bj][m][n] = __builtin_amdgcn_mfma_f32_16x16x32_bf16(Bt[n][k], At[m][k], acc[ai][bj][m][n], 0, 0, 0); __builtin_amdgcn_s_setprio(0); } while (0)
#define PG8_WAIT_V(n) asm volatile("s_waitcnt vmcnt(" #n ")" ::: "memory")
#define PG8_WAIT_L(n) asm volatile("s_waitcnt lgkmcnt(" #n ")" ::: "memory")
#define PG8_BAR __builtin_amdgcn_s_barrier()
#define PG8_SCHED __builtin_amdgcn_sched_barrier(0)
    Unit cur, nxt; int ui = 0;
    if (!S.next(0, cur)) return;
    f32x4 acc[2][2][4][2];
#pragma unroll
    for (int a = 0; a < 2; ++a)
#pragma unroll
        for (int b = 0; b < 2; ++b)
#pragma unroll
            for (int m = 0; m < 4; ++m)
#pragma unroll
                for (int n = 0; n < 2; ++n) acc[a][b][m][n] = (f32x4){0.f, 0.f, 0.f, 0.f};
    bf16x8 At[4][2], B0[2][2], B1[2][2];
    const char* cA = (const char*)g.A + (size_t)cur.pm * tstep; const char* cB = (const char*)g.Bt + (size_t)cur.pn * tstep;
    S.a_ready(cur);
    if constexpr (SP2) {
        PG8_STAGE(PG8_SB(0, 0), cB, voffB); PG8_STAGE(PG8_SB(0, 1), cB + hstep, voffB); PG8_STAGE(PG8_SA(0, 0), cA, voffA); PG8_STAGE(PG8_SA(0, 1), cA + hstep, voffA);
        if (wr == 1) PG8_BAR;
        PG8_WAIT_V(2); PG8_BAR;
        PG8_STAGE(PG8_SB(1, 0), cB + kstep, voffB); PG8_STAGE(PG8_SA(1, 0), cA + kstep, voffA); PG8_STAGE(PG8_SB(1, 1), cB + hstep + kstep, voffB);
        PG8_WAIT_V(6); PG8_BAR;
    } else {
        PG8_STAGE(PG8_SB(0, 0), cB, voffB); PG8_STAGE(PG8_SA(0, 0), cA, voffA); PG8_STAGE(PG8_SB(0, 1), cB + hstep, voffB); PG8_STAGE(PG8_SA(0, 1), cA + hstep, voffA);
        if (wr == 1) PG8_BAR;
        PG8_WAIT_V(4); PG8_BAR;
        PG8_STAGE(PG8_SB(1, 0), cB + kstep, voffB); PG8_STAGE(PG8_SA(1, 0), cA + kstep, voffA); PG8_STAGE(PG8_SB(1, 1), cB + hstep + kstep, voffB);
        PG8_WAIT_V(6); PG8_BAR;
    }
    for (;;) {
        const bool has_next = S.next(ui + 1, nxt);
        const char* nA = has_next ? (const char*)g.A + (size_t)nxt.pm * tstep : cA; const char* nB = has_next ? (const char*)g.Bt + (size_t)nxt.pn * tstep : cB;
        for (int t = 0; t < nt; t += 2) {
            const bool last = (t == nt - 2);
            const char* a1 = cA + (size_t)(t + 1) * kstep;
            const char* a2 = last ? nA : cA + (size_t)(t + 2) * kstep; const char* b2 = last ? nB : cB + (size_t)(t + 2) * kstep;
            const char* a3 = a2 + kstep; const char* b3 = b2 + kstep;
            if (last && has_next) S.a_ready(nxt);
            if constexpr (SP2) {
            PG8_LDB(B0, 0, 0); PG8_LDB(B1, 0, 1); PG8_SCHED; PG8_LDA(At, 0, 0); PG8_STAGE(PG8_SA(1, 1), a1 + hstep, voffA);
            PG8_WAIT_V(8); PG8_WAIT_L(0); PG8_BAR; PG8_MMA(0, 0, At, B0); PG8_MMA(0, 1, At, B1); PG8_BAR; PG8_SCHED;
            PG8_LDA(At, 0, 1); PG8_STAGE(PG8_SB(0, 0), b2, voffB); PG8_STAGE(PG8_SB(0, 1), b2 + hstep, voffB); PG8_STAGE(PG8_SA(0, 0), a2, voffA);
            PG8_WAIT_V(8); PG8_WAIT_L(0); PG8_BAR; PG8_MMA(1, 0, At, B0); PG8_MMA(1, 1, At, B1); PG8_BAR; PG8_SCHED;
            PG8_LDB(B0, 1, 0); PG8_LDB(B1, 1, 1); PG8_SCHED; PG8_LDA(At, 1, 0); PG8_STAGE(PG8_SA(0, 1), a2 + hstep, voffA);
            PG8_WAIT_V(8); PG8_WAIT_L(0); PG8_BAR; PG8_MMA(0, 0, At, B0); PG8_MMA(0, 1, At, B1); PG8_BAR; PG8_SCHED;
            PG8_LDA(At, 1, 1); PG8_STAGE(PG8_SB(1, 0), b3, voffB); PG8_STAGE(PG8_SB(1, 1), b3 + hstep, voffB); PG8_STAGE(PG8_SA(1, 0), a3, voffA);
            PG8_WAIT_V(8); PG8_WAIT_L(0); PG8_BAR; PG8_MMA(1, 0, At, B0); PG8_MMA(1, 1, At, B1); PG8_BAR; PG8_SCHED;
            } else {
            PG8_LDB(B0, 0, 0); PG8_SCHED; PG8_LDA(At, 0, 0); PG8_STAGE(PG8_SA(1, 1), a1 + hstep, voffA);
            PG8_WAIT_L(8); PG8_BAR; PG8_WAIT_L(0); PG8_MMA(0, 0, At, B0); PG8_BAR; PG8_SCHED;
            PG8_LDB(B1, 0, 1); PG8_STAGE(PG8_SB(0, 0), b2, voffB);
            PG8_BAR; PG8_WAIT_L(0); PG8_MMA(0, 1, At, B1); PG8_BAR;
            PG8_LDA(At, 0, 1); PG8_STAGE(PG8_SA(0, 0), a2, voffA);
            PG8_BAR; PG8_WAIT_L(0); PG8_MMA(1, 0, At, B0); PG8_BAR; PG8_SCHED;
            PG8_STAGE(PG8_SB(0, 1), b2 + hstep, voffB);
            PG8_WAIT_V(6); PG8_BAR; PG8_MMA(1, 1, At, B1); PG8_BAR;
            PG8_LDB(B0, 1, 0); PG8_SCHED; PG8_LDA(At, 1, 0); PG8_STAGE(PG8_SA(0, 1), a2 + hstep, voffA);
            PG8_WAIT_L(8); PG8_BAR; PG8_WAIT_L(0); PG8_MMA(0, 0, At, B0); PG8_BAR; PG8_SCHED;
            PG8_LDB(B1, 1, 1); PG8_STAGE(PG8_SB(1, 0), b3, voffB);
            PG8_BAR; PG8_WAIT_L(0); PG8_MMA(0, 1, At, B1); PG8_BAR;
            PG8_LDA(At, 1, 1); PG8_STAGE(PG8_SA(1, 0), a3, voffA);
            PG8_BAR; PG8_WAIT_L(0); PG8_MMA(1, 0, At, B0); PG8_BAR; PG8_SCHED;
            PG8_STAGE(PG8_SB(1, 1), b3 + hstep, voffB);
            PG8_WAIT_V(6); PG8_BAR; PG8_MMA(1, 1, At, B1); PG8_BAR;
            }
        }
        if constexpr (ALIGN_EPI) { if (wr == 0) PG8_BAR; }
        if constexpr (!Epi::AFTER_DRAIN) { E(acc, cur, wr, wc, fr, fq); S.done(cur); }
        if (!has_next) break;
#pragma unroll
        for (int a = 0; a < 2; ++a)
#pragma unroll
            for (int b = 0; b < 2; ++b)
#pragma unroll
                for (int m = 0; m < 4; ++m)
#pragma unroll
                    for (int n = 0; n < 2; ++n) acc[a][b][m][n] = (f32x4){0.f, 0.f, 0.f, 0.f};
        cur = nxt; cA = nA; cB = nB; ++ui;
        if constexpr (ALIGN_EPI) { if (wr == 1) PG8_BAR; }
    }
    PG8_WAIT_V(0);
    if constexpr (!ALIGN_EPI) { if (wr == 0) PG8_BAR; }
    PG8_BAR;
    if constexpr (Epi::AFTER_DRAIN) { E.fused(acc, cur, wr, wc, fr, fq, lds, wid, lane); S.done(cur); }
#undef PG8_SA
#undef PG8_SB
#undef PG8_STAGE
#undef PG8_LDA
#undef PG8_LDB
#undef PG8_MMA
#undef PG8_WAIT_V
#undef PG8_WAIT_L
#undef PG8_BAR
#undef PG8_SCHED
}
}

namespace pg8 {
typedef unsigned u32x2 __attribute__((ext_vector_type(2)));
__host__ __device__ __forceinline__ int slot_col(int s, bool mapf) { const int bj = s >> 7, wc = (s >> 5) & 3, n = (s >> 4) & 1, fq = (s >> 2) & 3, e = s & 3;
    return mapf ? 64 * wc + 32 * bj + 16 * n + 4 * fq + e : 64 * wc + 32 * bj + 8 * fq + 4 * n + e; }

__device__ __forceinline__ void load_rstd(const float* __restrict__ rowss, int grow0, float (&rs)[2][4], int lane, int fr) {
    float t[2][8];
#pragma unroll
    for (int ai = 0; ai < 2; ++ai)
#pragma unroll
        for (int k = 0; k < 8; ++k) t[ai][k] = rowss[(size_t)k * MTOT + grow0 + 128 * ai + lane];
#pragma unroll
    for (int ai = 0; ai < 2; ++ai) {
        const float s = ((t[ai][0] + t[ai][1]) + (t[ai][2] + t[ai][3])) + ((t[ai][4] + t[ai][5]) + (t[ai][6] + t[ai][7]));
        const float r = rsqrtf(s * (1.0f / DM) + EPS);
#pragma unroll
        for (int m = 0; m < 4; ++m) rs[ai][m] = __shfl(r, 16 * m + fr);
    }
}
__device__ __forceinline__ void st16(void* p, u32x4 v) { *(u32x4*)p = v; }
__device__ __forceinline__ void st16f(float* p, f32x4 v) { st16((void*)p, __builtin_bit_cast(u32x4, v)); }
__device__ __forceinline__ float fq_sum(float v) {
    auto a = __builtin_amdgcn_permlane16_swap(__float_as_uint(v), __float_as_uint(v), false, false); const float s = __uint_as_float(a[0]) + __uint_as_float(a[1]);
    auto b = __builtin_amdgcn_permlane32_swap(__float_as_uint(s), __float_as_uint(s), false, false); return __uint_as_float(b[0]) + __uint_as_float(b[1]);
}
__device__ __forceinline__ u32x4 pack_bf16_8(const float (&v)[8]) {
    u32x4 w; w.x = cvt_pk_bf16(v[0], v[1]); w.y = cvt_pk_bf16(v[2], v[3]); w.z = cvt_pk_bf16(v[4], v[5]); w.w = cvt_pk_bf16(v[6], v[7]); return w;
}

struct EpiA {
    static constexpr bool PERM = false, AFTER_DRAIN = false;
    bf16_t* P; const float* rowss; const float* gq; const float* gk;
    __device__ __forceinline__ void operator()(const f32x4 (&acc)[2][2][4][2], const Unit& u, int wr, int wc, int fr, int fq) const {
        const int lane = fr + 16 * fq; const int rbase = u.pm * BM + wr * 64;
        float rs[2][4]; load_rstd(rowss, rbase, rs, lane, fr);
        const int col0 = u.pn * BM + wc * 64 + 8 * fq;
        const int mode = u.pn < 4 ? 1 : (u.pn < 8 ? 2 : 0);
        float g[2][8];
        if (mode) { const float* gp = (mode == 1 ? gq : gk) + 8 * fq; const float sc = (mode == 1) ? QSCALE_D : 1.0f;
#pragma unroll
            for (int bj = 0; bj < 2; ++bj)
#pragma unroll
                for (int i = 0; i < 8; ++i) g[bj][i] = gp[32 * bj + i] * sc; }
        else {
#pragma unroll
            for (int bj = 0; bj < 2; ++bj)
#pragma unroll
                for (int i = 0; i < 8; ++i) g[bj][i] = 1.f; }
#pragma unroll
        for (int ai = 0; ai < 2; ++ai)
#pragma unroll
            for (int m = 0; m < 4; ++m) {
                float v[2][8]; const float r = rs[ai][m];
#pragma unroll
                for (int bj = 0; bj < 2; ++bj)
#pragma unroll
                    for (int n = 0; n < 2; ++n)
#pragma unroll
                        for (int e = 0; e < 4; ++e) v[bj][4 * n + e] = acc[ai][bj][m][n][e] * r;
                if (mode) {
                    float ss = 0.f;
#pragma unroll
                    for (int bj = 0; bj < 2; ++bj)
#pragma unroll
                        for (int i = 0; i < 8; ++i) ss += v[bj][i] * v[bj][i];
                    ss = fq_sum(ss);
                    const float rn = rsqrtf(ss * (1.0f / 64.0f) + EPS);
#pragma unroll
                    for (int bj = 0; bj < 2; ++bj)
#pragma unroll
                        for (int i = 0; i < 8; ++i) v[bj][i] = v[bj][i] * rn * g[bj][i];
                }
                bf16_t* dst = P + (size_t)(rbase + ai * HALF + m * 16 + fr) * NIN + col0;
                st16(dst, pack_bf16_8(v[0])); st16(dst + 32, pack_bf16_8(v[1]));
                asm volatile("" ::: "memory");
            }
    }
};
struct EpiRelu2 {
    static constexpr bool PERM = false, AFTER_DRAIN = false;
    bf16_t* H; const float* rowss; int m0;
    __device__ __forceinline__ void operator()(const f32x4 (&acc)[2][2][4][2], const Unit& u, int wr, int wc, int fr, int fq) const {
        const int lane = fr + 16 * fq; const int rbase = u.pm * BM + wr * 64;
        float rs[2][4]; load_rstd(rowss, m0 + rbase, rs, lane, fr);
        const int col0 = u.pn * BM + wc * 64 + 8 * fq;
#pragma unroll
        for (int ai = 0; ai < 2; ++ai)
#pragma unroll
            for (int m = 0; m < 4; ++m) {
                float v[2][8]; const float r = rs[ai][m];
#pragma unroll
                for (int bj = 0; bj < 2; ++bj)
#pragma unroll
                    for (int n = 0; n < 2; ++n)
#pragma unroll
                        for (int e = 0; e < 4; ++e) { const float t = fmaxf(acc[ai][bj][m][n][e] * r, 0.f); v[bj][4 * n + e] = t * t; }
                bf16_t* dst = H + (size_t)(rbase + ai * HALF + m * 16 + fr) * DFF + col0;
                st16(dst, pack_bf16_8(v[0])); st16(dst + 32, pack_bf16_8(v[1]));
                asm volatile("" ::: "memory");
            }
    }
};
template <bool FIRST>
struct EpiResB {
    static constexpr bool PERM = false, AFTER_DRAIN = false;
    bf16_t* XB; const float* x0f; float* outf; float* rowss; int m0; PG8_LAS float* scr; int final;
    __device__ __forceinline__ void operator()(const f32x4 (&acc)[2][2][4][2], const Unit& u, int wr, int wc, int fr, int fq) const {
        const int rbase = m0 + u.pm * BM + wr * 64; const int col0 = u.pn * BM + wc * 64 + 8 * fq;
        u32x4 raw[2][4][2];
        if constexpr (!FIRST) {
#pragma unroll
            for (int ai = 0; ai < 2; ++ai)
#pragma unroll
                for (int m = 0; m < 4; ++m) { const bf16_t* src = XB + (size_t)(rbase + ai * HALF + m * 16 + fr) * DM + col0;
#pragma unroll
                    for (int bj = 0; bj < 2; ++bj) raw[ai][m][bj] = *(const u32x4*)(src + 32 * bj); }
        }
#pragma unroll
        for (int ai = 0; ai < 2; ++ai) {
            f32x4 xf[4][2][2];
            if constexpr (FIRST) {
#pragma unroll
                for (int m = 0; m < 4; ++m) { const float* src = x0f + (size_t)(rbase + ai * HALF + m * 16 + fr) * DM + col0;
#pragma unroll
                    for (int bj = 0; bj < 2; ++bj) { xf[m][bj][0] = *(const f32x4*)(src + 32 * bj); xf[m][bj][1] = *(const f32x4*)(src + 32 * bj + 4); } }
            }
#pragma unroll
            for (int m = 0; m < 4; ++m) {
                const size_t roff = (size_t)(rbase + ai * HALF + m * 16 + fr) * DM + col0;
                float ss = 0.f;
#pragma unroll
                for (int bj = 0; bj < 2; ++bj) {
                    float xo[8];
                    if constexpr (FIRST) {
#pragma unroll
                        for (int k = 0; k < 4; ++k) { xo[k] = xf[m][bj][0][k]; xo[4 + k] = xf[m][bj][1][k]; }
                    } else {
#pragma unroll
                        for (int k = 0; k < 4; ++k) { const unsigned w = raw[ai][m][bj][k]; xo[2 * k] = __uint_as_float(w << 16); xo[2 * k + 1] = __uint_as_float(w & 0xffff0000u); }
                    }
                    float v[8];
#pragma unroll
                    for (int n = 0; n < 2; ++n)
#pragma unroll
                        for (int e = 0; e < 4; ++e) { const float t = acc[ai][bj][m][n][e] + xo[4 * n + e]; v[4 * n + e] = t; ss += t * t; }
                    if (final) { st16f(outf + roff + 32 * bj, (f32x4){v[0], v[1], v[2], v[3]}); st16f(outf + roff + 32 * bj + 4, (f32x4){v[4], v[5], v[6], v[7]}); }
                    else st16(XB + roff + 32 * bj, pack_bf16_8(v));
                }
                ss = fq_sum(ss);
                if (fq == 0) scr[wc * 256 + ai * HALF + wr * 64 + m * 16 + fr] = ss;
            }
            asm volatile("" ::: "memory");
        }
        asm volatile("s_waitcnt lgkmcnt(0)" ::: "memory"); __builtin_amdgcn_s_barrier(); asm volatile("" ::: "memory");
        int tid = threadIdx.x; asm volatile("" : "+v"(tid));
        if (tid < 256) rowss[(size_t)u.pn * MTOT + m0 + u.pm * BM + tid] = (scr[tid] + scr[256 + tid]) + (scr[512 + tid] + scr[768 + tid]);
    }
};
struct EpiF32 {
    static constexpr bool PERM = false, AFTER_DRAIN = false;
    float* O; int ldc;
    __device__ __forceinline__ void operator()(const f32x4 (&acc)[2][2][4][2], const Unit& u, int wr, int wc, int fr, int fq) const {
        const int rbase = u.pm * BM + wr * 64; const int col0 = u.pn * BM + wc * 64 + 4 * fq;
#pragma unroll
        for (int ai = 0; ai < 2; ++ai)
#pragma unroll
            for (int m = 0; m < 4; ++m) { float* rowp = O + (size_t)(rbase + ai * HALF + m * 16 + fr) * ldc + col0;
#pragma unroll
                for (int bj = 0; bj < 2; ++bj)
#pragma unroll
                    for (int n = 0; n < 2; ++n) *(f32x4*)(rowp + 32 * bj + 16 * n) = acc[ai][bj][m][n]; }
    }
};
}

#define GAS __attribute__((address_space(1)))
#define LAS __attribute__((address_space(3)))
typedef unsigned short bf16;
typedef unsigned v4u __attribute__((ext_vector_type(4)));
typedef float f32x4 __attribute__((ext_vector_type(4)));
typedef short bf16x8 __attribute__((ext_vector_type(8)));
typedef GAS unsigned gu32;
typedef GAS unsigned long long gu64;
#define RLX_AGENT __ATOMIC_RELAXED, __HIP_MEMORY_SCOPE_AGENT
#define LDS_WAIT() asm volatile("s_waitcnt lgkmcnt(0)" ::: "memory")
#define VM_WAIT() asm volatile("s_waitcnt vmcnt(0)" ::: "memory")
__device__ __forceinline__ unsigned long long rt() { return __builtin_amdgcn_s_memrealtime(); }
__device__ __forceinline__ unsigned f2bf(float f) { unsigned u = __builtin_bit_cast(unsigned, f); return (u + 0x7fffu + ((u >> 16) & 1u)) >> 16; }
__device__ __forceinline__ unsigned pk2(float lo, float hi) { return f2bf(lo) | (f2bf(hi) << 16); }

#define XB_TMO      128
#define XB_XCNT(j)  (256  + 64 * (j))
#define XB_XSUB(j)  (1280 + 64 * (j))
#define XB_XGEN(j)  (2304 + 64 * (j))
#define XB_TOP      3328
#define XB_TOPGEN   3392
#define XCD_BAR_WORDS 3456
#define XB_SPIN_CAP (1u << 18)

__device__ __forceinline__ unsigned xb_ld(unsigned* p)              { return __hip_atomic_load(p, __ATOMIC_RELAXED, __HIP_MEMORY_SCOPE_AGENT); }
__device__ __forceinline__ unsigned xb_add(unsigned* p, unsigned v) { return __hip_atomic_fetch_add(p, v, __ATOMIC_RELAXED, __HIP_MEMORY_SCOPE_AGENT); }
__device__ __forceinline__ unsigned xb_xcc_id() { return (unsigned)__builtin_amdgcn_s_getreg((3 << 11) | 20) & 0xFu; }
#define XB_SPIN(cond, bar) do { unsigned _sp = 0; while (cond) { __builtin_amdgcn_s_sleep(1); \
    if ((++_sp & 255u) == 0u) { if (xb_ld(&(bar)[XB_TMO])) break; if (_sp > XB_SPIN_CAP) { atomicAdd(&(bar)[XB_TMO], 1u); break; } } } } while (0)

struct XcdBarrier {
    unsigned* bar; unsigned x;
    volatile LAS unsigned* st;
};

__device__ __forceinline__ XcdBarrier xcd_barrier_post(unsigned* bar, volatile LAS unsigned* st) {
    XcdBarrier b; b.bar = bar; b.x = xb_xcc_id(); b.st = st;
    if (threadIdx.x == 0) (void)xb_add(&bar[XB_XCNT(b.x)], 1u);
    return b;
}
__device__ __forceinline__ void xcd_barrier_complete(unsigned* bar, unsigned x, unsigned& nloc, unsigned& nx) {
    const unsigned G = gridDim.x * gridDim.y * gridDim.z;
    unsigned sum, cnt, mine, sp = 0u;
    for (;;) {
        sum = 0u; cnt = 0u; mine = 0u;
#pragma unroll
        for (unsigned j = 0; j < 16; ++j) { const unsigned c = xb_ld(&bar[XB_XCNT(j)]); sum += c; cnt += (c > 0u) ? 1u : 0u; mine = (j == x) ? c : mine; }
        if (sum == G) break;
        __builtin_amdgcn_s_sleep(1);
        if ((++sp & 255u) == 0u) { if (xb_ld(&bar[XB_TMO])) break; if (sp > XB_SPIN_CAP) { atomicAdd(&bar[XB_TMO], 1u); break; } }
    }
    nloc = mine > 0u ? mine : 1u; nx = cnt > 0u ? cnt : 1u;
}

__device__ __forceinline__ void xcd_barrier(const XcdBarrier& b) {
    asm volatile("s_waitcnt vmcnt(0)" ::: "memory");
    __syncthreads();
    if (threadIdx.x == 0) {
        GAS unsigned* barg = (GAS unsigned*)b.bar; asm volatile("" : "+s"(barg)); unsigned* bar = (unsigned*)barg;
        __builtin_amdgcn_s_waitcnt(0);
        unsigned nloc = b.st[0], nx = b.st[1];
        if (nloc == 0u) { xcd_barrier_complete(bar, b.x, nloc, nx); b.st[0] = nloc; b.st[1] = nx; }
        const unsigned old = xb_add(&bar[XB_XSUB(b.x)], 1u);
        const unsigned gen = old / nloc;
        if (old + 1u == (gen + 1u) * nloc) {
            __builtin_amdgcn_fence(__ATOMIC_RELEASE, "agent");
            asm volatile("s_waitcnt vmcnt(0)" ::: "memory");
            const unsigned og = xb_add(&bar[XB_TOP], 1u);
            const unsigned tg = og / nx;
            if (og + 1u == (tg + 1u) * nx) xb_add(&bar[XB_TOPGEN], 1u);
            else XB_SPIN(xb_ld(&bar[XB_TOPGEN]) == tg, bar);
            __builtin_amdgcn_fence(__ATOMIC_ACQUIRE, "agent");
            xb_add(&bar[XB_XGEN(b.x)], 1u);
            asm volatile("s_waitcnt vmcnt(0)" ::: "memory");
        } else {
            XB_SPIN(xb_ld(&bar[XB_XGEN(b.x)]) == gen, bar);
            __builtin_amdgcn_fence(__ATOMIC_ACQUIRE, "agent");
            asm volatile("s_waitcnt vmcnt(0)" ::: "memory");
        }
    }
    __syncthreads();
}


__device__ __forceinline__ float wave_sum(float v) {
#pragma unroll
    for (int o = 1; o < 64; o <<= 1) v += __shfl_xor(v, o);
    return v;
}
__device__ __forceinline__ float bf2f(short s) { return __uint_as_float(((unsigned)(unsigned short)s) << 16); }
__device__ __forceinline__ bf16x8 pack8(const float (&f)[8]) {
    v4u w; w.x = pg8::cvt_pk_bf16(f[0], f[1]); w.y = pg8::cvt_pk_bf16(f[2], f[3]); w.z = pg8::cvt_pk_bf16(f[4], f[5]); w.w = pg8::cvt_pk_bf16(f[6], f[7]);
    return __builtin_bit_cast(bf16x8, w);
}

namespace att {
using s16x4  = __attribute__((ext_vector_type(4))) short;
using f32x16 = __attribute__((ext_vector_type(16))) float;
constexpr int KVBLK = 64;
constexpr int SHM_V = KVBLK * 128 * 2, SHM_K = KVBLK * 128 * 2;
constexpr int NBUF = 3;
constexpr int OFF_V = 0, OFF_K = NBUF * SHM_V, OFF_WS = NBUF * (SHM_V + SHM_K), OFF_X = 0  , ATT_LDS = OFF_WS + 8 * 64 * 4;
static_assert(4 * 4096 * 4 <= OFF_WS && 8 * 32 * 272 <= OFF_WS, "exchange buffer / output staging tiles fit the tile ring");
constexpr float THR2 = 8.f * LOG2E;
#define KSWZ(row, colB) ((row) * 256 + ((colB) ^ (((row) & 7) << 4)))
#define SBAR() __builtin_amdgcn_sched_barrier(0)
__device__ __forceinline__ int crow(int r, int hi) { return (r & 3) + 8 * (r >> 2) + 4 * hi; }

#define NOPK(x) asm("" : "+v"(x))
template <int MODE>
__device__ __forceinline__ void score_init(f32x16& p0, f32x16& p1, float m_reg, float mh2, float dq, int cls) {
  if constexpr (MODE == 0) {
    if (cls == 0) {
#pragma unroll
      for (int r = 0; r < 16; ++r) { const float c = (float)((r & 3) + 8 * (r >> 2));
        float a = fmaf(-mh2, fabsf(dq - c), -m_reg), b = fmaf(-mh2, fabsf(dq - (c + 32.f)), -m_reg); NOPK(a); NOPK(b); p0[r] = a; p1[r] = b; }
    } else {
      const float sm = cls > 0 ? mh2 : -mh2; const float base = fmaf(-sm, dq, -m_reg);
#pragma unroll
      for (int r = 0; r < 16; ++r) { const float c = (float)((r & 3) + 8 * (r >> 2));
        float a = fmaf(c, sm, base), b = fmaf(c + 32.f, sm, base); NOPK(a); NOPK(b); p0[r] = a; p1[r] = b; }
    }
  } else {
#pragma unroll
    for (int r = 0; r < 16; ++r) { p0[r] = -m_reg; p1[r] = -m_reg; }
  }
}
__device__ __forceinline__ void score_init_mono(f32x16& p0, f32x16& p1, float m_reg, float mh2, float dq, bool left) {
  const float sm = left ? mh2 : -mh2; const float base = fmaf(-sm, dq, -m_reg);
#pragma unroll
  for (int r = 0; r < 16; ++r) { const float c = (float)((r & 3) + 8 * (r >> 2));
    float a = fmaf(c, sm, base), b = fmaf(c + 32.f, sm, base); NOPK(a); NOPK(b); p0[r] = a; p1[r] = b; }
}
template <bool FIXED>
__device__ __forceinline__ void partialSM(f32x16& p0, f32x16& p1, float& m_reg, float& alpha) {
  if constexpr (FIXED) { alpha = 1.f;
#pragma unroll
    for (int r = 0; r < 16; ++r) p0[r] = __builtin_amdgcn_exp2f(p0[r]);
    return; }
  float pmax = p0[0];
#pragma unroll
  for (int r = 1; r < 16; ++r) pmax = fmaxf(pmax, p0[r]);
#pragma unroll
  for (int r = 0; r < 16; ++r) pmax = fmaxf(pmax, p1[r]);
  { auto rr = __builtin_amdgcn_permlane32_swap(__float_as_uint(pmax), __float_as_uint(pmax), false, false);
    pmax = fmaxf(__uint_as_float(rr[0]), __uint_as_float(rr[1])); }
  if (__builtin_expect(__all(pmax <= THR2), 1)) { alpha = 1.f; }
  else { const float d = fmaxf(pmax, 0.f); alpha = __builtin_amdgcn_exp2f(-d); m_reg += d;
#pragma unroll
    for (int r = 0; r < 16; ++r) { p0[r] = p0[r] - d; p1[r] = p1[r] - d; } }
#pragma unroll
  for (int r = 0; r < 16; ++r) p0[r] = __builtin_amdgcn_exp2f(p0[r]);
}
__device__ __forceinline__ void finishSM(f32x16& p0, f32x16& p1, float alpha, float& l_reg, bf16x8& pa0, bf16x8& pa1, bf16x8& pa2, bf16x8& pa3) {
#pragma unroll
  for (int r = 0; r < 16; ++r) p1[r] = __builtin_amdgcn_exp2f(p1[r]);
  float ps = 0;
#pragma unroll
  for (int r = 0; r < 16; ++r) ps += p0[r];
#pragma unroll
  for (int r = 0; r < 16; ++r) ps += p1[r];
  { auto rr = __builtin_amdgcn_permlane32_swap(__float_as_uint(ps), __float_as_uint(ps), false, false);
    ps = __uint_as_float(rr[0]) + __uint_as_float(rr[1]); }
  l_reg = l_reg * alpha + ps;
#define PK4(P, BASE, OUT) do { unsigned a0 = pg8::cvt_pk_bf16(P[BASE + 0], P[BASE + 1]), a1 = pg8::cvt_pk_bf16(P[BASE + 2], P[BASE + 3]);   \
    unsigned b0 = pg8::cvt_pk_bf16(P[BASE + 4], P[BASE + 5]), b1 = pg8::cvt_pk_bf16(P[BASE + 6], P[BASE + 7]);                              \
    auto r0 = __builtin_amdgcn_permlane32_swap(a0, b0, false, false); auto r1 = __builtin_amdgcn_permlane32_swap(a1, b1, false, false); \
    v4u w = {r0[0], r1[0], r0[1], r1[1]}; OUT = __builtin_bit_cast(bf16x8, w); } while (0)
  PK4(p0, 0, pa0); PK4(p0, 8, pa1); PK4(p1, 0, pa2); PK4(p1, 8, pa3);
#undef PK4
}
template <int ND0>
__device__ __forceinline__ void qkt(f32x16& p0, f32x16& p1, LAS const char* Ks, const bf16x8* qr, int r32, int hi, int dcol0) {
#pragma unroll
  for (int d0 = 0; d0 < ND0; ++d0) { const int cb = (dcol0 + d0 * 16 + hi * 8) * 2;
    const bf16x8 b0 = *(LAS const bf16x8*)(Ks + KSWZ(r32, cb));
    const bf16x8 b1 = *(LAS const bf16x8*)(Ks + KSWZ(32 + r32, cb));
    p0 = __builtin_amdgcn_mfma_f32_32x32x16_bf16(b0, qr[d0], p0, 0, 0, 0);
    p1 = __builtin_amdgcn_mfma_f32_32x32x16_bf16(b1, qr[d0], p1, 0, 0, 0); }
}
__device__ __forceinline__ void qkt_load4(bf16x8 (&kf)[4][2], LAS const char* Ks, int r32, int hi, int dcol0) {
#pragma unroll
  for (int d0 = 0; d0 < 4; ++d0) { const int cb = (dcol0 + d0 * 16 + hi * 8) * 2;
    kf[d0][0] = *(LAS const bf16x8*)(Ks + KSWZ(r32, cb)); kf[d0][1] = *(LAS const bf16x8*)(Ks + KSWZ(32 + r32, cb)); }
}
__device__ __forceinline__ void qkt_mma4(f32x16& p0, f32x16& p1, const bf16x8 (&kf)[4][2], const bf16x8* qr) {
#pragma unroll
  for (int d0 = 0; d0 < 4; ++d0) {
    p0 = __builtin_amdgcn_mfma_f32_32x32x16_bf16(kf[d0][0], qr[d0], p0, 0, 0, 0);
    p1 = __builtin_amdgcn_mfma_f32_32x32x16_bf16(kf[d0][1], qr[d0], p1, 0, 0, 0); }
}
__device__ __forceinline__ int v_st(int k, int c) { const int kk = (k & ~0xC) | ((k & 4) << 1) | ((k & 8) >> 1); return ((kk >> 3) * 4 + (c >> 5)) * 512 + ((kk & 7) * 32 + (c & 31)) * 2; }
__device__ __forceinline__ int v_rd_base(int lane) { return ((lane & 3) << 3) | (((lane >> 2) & 3) << 6) | (((lane >> 4) & 1) << 5) | (((lane >> 5) & 1) << 8); }
constexpr int v_rd_off(int d0, int ks, int half) { return d0 * 512 + ks * 4096 + half * 2048; }
typedef short v4i16_t __attribute__((ext_vector_type(4)));
template <int OFF> __device__ __forceinline__ s16x4 tr_read(int vb) {
  return __builtin_bit_cast(s16x4, __builtin_amdgcn_ds_read_tr16_b64_v4i16((LAS v4i16_t*)(uintptr_t)(unsigned)(vb + OFF)));
}
template <int D0> __device__ __forceinline__ void pv_one(f32x16& od, int vb, bf16x8 pa0, bf16x8 pa1, bf16x8 pa2, bf16x8 pa3) {
  const s16x4 l0 = tr_read<v_rd_off(D0, 0, 0)>(vb), h0 = tr_read<v_rd_off(D0, 0, 1)>(vb), l1 = tr_read<v_rd_off(D0, 1, 0)>(vb), h1 = tr_read<v_rd_off(D0, 1, 1)>(vb);
  const s16x4 l2 = tr_read<v_rd_off(D0, 2, 0)>(vb), h2 = tr_read<v_rd_off(D0, 2, 1)>(vb), l3 = tr_read<v_rd_off(D0, 3, 0)>(vb), h3 = tr_read<v_rd_off(D0, 3, 1)>(vb);
#define PK(L, H) (bf16x8){L[0], L[1], L[2], L[3], H[0], H[1], H[2], H[3]}
  od = __builtin_amdgcn_mfma_f32_32x32x16_bf16(pa0, PK(l0, h0), od, 0, 0, 0);
  od = __builtin_amdgcn_mfma_f32_32x32x16_bf16(pa1, PK(l1, h1), od, 0, 0, 0);
  od = __builtin_amdgcn_mfma_f32_32x32x16_bf16(pa2, PK(l2, h2), od, 0, 0, 0);
  od = __builtin_amdgcn_mfma_f32_32x32x16_bf16(pa3, PK(l3, h3), od, 0, 0, 0);
#undef PK
}
__device__ __forceinline__ void pv_d0(f32x16* o, int vb, bf16x8 pa0, bf16x8 pa1, bf16x8 pa2, bf16x8 pa3) {
  pv_one<0>(o[0], vb, pa0, pa1, pa2, pa3); pv_one<1>(o[1], vb, pa0, pa1, pa2, pa3); pv_one<2>(o[2], vb, pa0, pa1, pa2, pa3); pv_one<3>(o[3], vb, pa0, pa1, pa2, pa3);
}

constexpr int TPITCH = 272, TBYTES = 32 * TPITCH;
#define ATT_STORE_TILE(T, VAL) do { \
    _Pragma("unroll") for (int r = 0; r < 16; ++r) _Pragma("unroll") for (int d0 = 0; d0 < 4; ++d0) \
      *(LAS unsigned short*)((T) + crow(r, hi) * TPITCH + (d0 * 32 + r32) * 2) = (unsigned short)f2bf(VAL); \
    asm volatile("s_waitcnt lgkmcnt(0)" ::: "memory"); \
    _Pragma("unroll") for (int k = 0; k < 8; ++k) { const int c_ = lane + 64 * k, row_ = c_ >> 4, ch_ = c_ & 15; \
      const v4u w_ = *(LAS const v4u*)((T) + row_ * TPITCH + ch_ * 16); *(GAS v4u*)(Ow + (size_t)row_ * ldo + ch_ * 8) = w_; } } while (0)
__device__ __forceinline__ int tile_of(int i, int jd, int NT, int tlo) { int t = jd + i; t -= (t >= NT) ? NT : 0; return tlo + t; }
template <int MODE>
__device__ __forceinline__ unsigned attn_unit(LAS char* lds, const bf16* __restrict__ Qb, int ldq, const bf16* __restrict__ Kh, const bf16* __restrict__ Vh, int ldk,
                                          int NT, int jd, int tlo, float mh2, int qpos0, bf16* __restrict__ Ob, int ldo, const float* __restrict__ gvec, float lam, float osc, float mfix = 0.f, gu32* qnext = nullptr) {
  constexpr int ND0 = MODE == 0 ? 4 : 8;
  int tid_ = threadIdx.x; asm volatile("" : "+v"(tid_));
  const int tid = tid_, wid = __builtin_amdgcn_readfirstlane(tid >> 6), lane = tid & 63, r32 = lane & 31, hi = lane >> 5;
  const int map = MODE == 0 ? (wid >> 2) : 0, wq = MODE == 0 ? (wid & 3) : wid;
  LAS float* wsf = (LAS float*)(lds + OFF_WS) + wid * 64; LAS float* li_l = wsf; LAS float* al_l = wsf + 32;
  float m_reg = mfix, l_reg = 0; f32x16 o[4] = {}; bf16x8 qr[ND0];
  const bf16* Qw = Qb + (size_t)(wq * 32 + r32) * ldq + map * 64 + hi * 8;
  if constexpr (MODE == 0) {
#pragma unroll
    for (int d0 = 0; d0 < ND0; ++d0) qr[d0] = *(const bf16x8*)(Qw + d0 * 16);
  } else {
    float ss = 0.f;
#pragma unroll
    for (int d0 = 0; d0 < ND0; ++d0) { qr[d0] = *(const bf16x8*)(Qw + d0 * 16);
#pragma unroll
      for (int i = 0; i < 8; ++i) { const float f = bf2f(qr[d0][i]); ss += f * f; } }
    ss += __shfl_xor(ss, 32);
    const float rn = rsqrtf(ss * (1.0f / 128.0f) + EPS) * QSCALE_M;
#pragma unroll
    for (int d0 = 0; d0 < ND0; ++d0) { float f[8];
#pragma unroll
      for (int i = 0; i < 8; ++i) f[i] = bf2f(qr[d0][i]) * rn * gvec[d0 * 16 + hi * 8 + i];
      qr[d0] = pack8(f); }
  }
  const int vb0 = (int)(uintptr_t)(lds + OFF_V) + v_rd_base(lane);
  const float dqbase = (float)(qpos0 + wq * 32 + r32 - 4 * hi); const int qw0 = qpos0 + wq * 32;
  unsigned kofs[2], vofs[2];
#pragma unroll
  for (int q_ = 0; q_ < 2; ++q_) {
    const int krow = 8 * wid + 4 * q_ + (lane >> 4), kc = (lane & 15) ^ (krow & 7);
    kofs[q_] = (unsigned)krow * (unsigned)(ldk * 2) + (unsigned)kc * 16u;
    const int Q = (2 * wid + q_) * 64 + lane, st = Q >> 5, rr = Q & 31, kk = (st >> 2) * 8 + (rr >> 2), vc = (st & 3) * 32 + (rr & 3) * 8;
    const int vk = (kk & ~0xC) | ((kk & 4) << 1) | ((kk & 8) >> 1);
    vofs[q_] = (unsigned)vk * (unsigned)(ldk * 2) + (unsigned)vc * 2u;
  }
#define TILE_K0(i) (tile_of((i), jd, NT, tlo) * KVBLK)
#define DQ(i) (dqbase - (float)TILE_K0(i))
#define CLS(i) (TILE_K0(i) + 63 <= qw0 ? 1 : (TILE_K0(i) >= qw0 + 31 ? -1 : 0))
#define QK(P0, P1, KB, i) do { if constexpr (MODE == 0) { bf16x8 kf_[4][2]; qkt_load4(kf_, KB, r32, hi, map * 64); SBAR(); score_init<MODE>(P0, P1, m_reg, mh2, DQ(i), CLS(i)); qkt_mma4(P0, P1, kf_, qr); } \
    else { score_init<MODE>(P0, P1, m_reg, mh2, DQ(i), CLS(i)); qkt<ND0>(P0, P1, KB, qr, r32, hi, map * 64); } } while (0)
#define QKM(P0, P1, KB, i) do { bf16x8 kf_[4][2]; qkt_load4(kf_, KB, r32, hi, map * 64); SBAR(); score_init_mono(P0, P1, m_reg, mh2, DQ(i), TILE_K0(i) + 63 <= qw0); qkt_mma4(P0, P1, kf_, qr); } while (0)
#define DMA(slot, i) do { const size_t tb_ = (size_t)TILE_K0(i) * (size_t)(ldk * 2); \
    _Pragma("unroll") for (int q_ = 0; q_ < 2; ++q_) { \
      __builtin_amdgcn_global_load_lds((const unsigned*)((const char*)Kh + tb_ + kofs[q_]), (LAS unsigned*)(lds + OFF_K + (slot) * SHM_K + (2 * wid + q_) * 1024), 16, 0, 0); \
      __builtin_amdgcn_global_load_lds((const unsigned*)((const char*)Vh + tb_ + vofs[q_]), (LAS unsigned*)(lds + OFF_V + (slot) * SHM_V + (2 * wid + q_) * 1024), 16, 0, 0); } } while (0)
#define DWAIT() asm volatile("s_waitcnt vmcnt(0)" ::: "memory")
#define RESC(a) do { if (__any((a) < 1.f)) { if (hi == 0) al_l[r32] = (a); asm volatile("s_waitcnt lgkmcnt(0)" ::: "memory"); \
    _Pragma("unroll") for (int d = 0; d < 4; ++d) _Pragma("unroll") for (int r = 0; r < 16; ++r) o[d][r] *= al_l[crow(r, hi)]; } } while (0)
  f32x16 pA0, pA1, pB0, pB1; float alA, alB; bf16x8 pa0, pa1, pa2, pa3;
#define KB(b) (lds + OFF_K + (b) * SHM_K)
#define VB(b) (vb0 + (b) * SHM_V)
  int bp = 0, bq = 1, bw = 2;
  __syncthreads();
  DMA(0, 0); DMA(1, 1);
  DWAIT(); __syncthreads();
  if (wid >= 4) __builtin_amdgcn_s_setprio(1);
  QK(pA0, pA1, KB(0), 0); partialSM<true>(pA0, pA1, m_reg, alA);
#define BODY(QKX, QKY, j) do { \
    DMA(bw, (j) + 1);                                             \
    SBAR(); QKX(pB0, pB1, KB(bq), (j)); \
    finishSM(pA0, pA1, alA, l_reg, pa0, pa1, pa2, pa3); SBAR(); \
    pv_d0(o, VB(bp), pa0, pa1, pa2, pa3); partialSM<true>(pB0, pB1, m_reg, alB); \
    RESC(alB); DWAIT(); __syncthreads(); \
    bp = bq; bq = bw; bw = (bw == NBUF - 1) ? 0 : bw + 1; \
    DMA(bw, (j) + 2);                                             \
    SBAR(); QKY(pA0, pA1, KB(bq), (j) + 1); \
    finishSM(pB0, pB1, alB, l_reg, pa0, pa1, pa2, pa3); SBAR(); \
    pv_d0(o, VB(bp), pa0, pa1, pa2, pa3); partialSM<true>(pA0, pA1, m_reg, alA); \
    RESC(alA); DWAIT(); __syncthreads(); \
    bp = bq; bq = bw; bw = (bw == NBUF - 1) ? 0 : bw + 1; } while (0)
  if constexpr (MODE == 0) {
    if (NT > 2) BODY(QK, QKM, 1);
    for (int j = 3; j + 1 < NT; j += 2) BODY(QKM, QKM, j);
  } else {
    for (int j = 1; j + 1 < NT; j += 2) BODY(QK, QK, j);
  }
#undef BODY
  SBAR(); QK(pB0, pB1, KB(bq), NT - 1);
  finishSM(pA0, pA1, alA, l_reg, pa0, pa1, pa2, pa3); SBAR();
  pv_d0(o, VB(bp), pa0, pa1, pa2, pa3); partialSM<true>(pB0, pB1, m_reg, alB);
  RESC(alB);
  finishSM(pB0, pB1, alB, l_reg, pa0, pa1, pa2, pa3); SBAR();
  pv_d0(o, VB(bq), pa0, pa1, pa2, pa3);
#undef KB
#undef VB
  unsigned claimed = 0u;
  if (qnext != nullptr && tid == 0) claimed = __hip_atomic_fetch_add(qnext, 1u, RLX_AGENT);
  if (wid >= 4) __builtin_amdgcn_s_setprio(0);
  if (hi == 0) li_l[r32] = l_reg;
  asm volatile("s_waitcnt lgkmcnt(0)" ::: "memory");
  float rli[16];
#pragma unroll
  for (int r = 0; r < 16; ++r) rli[r] = __builtin_amdgcn_rcpf(li_l[crow(r, hi)]);
  bf16* Ow = Ob + (size_t)(wq * 32) * ldo;
  if constexpr (MODE == 1) {
    __syncthreads();
    LAS char* T = lds + wid * TBYTES;
    ATT_STORE_TILE(T, o[d0][r] * rli[r]);
  } else {
    LAS float* X = (LAS float*)(lds + OFF_X) + wq * 4096;
    __syncthreads();
    if (map == 1) {
#pragma unroll
      for (int d0 = 0; d0 < 4; ++d0)
#pragma unroll
        for (int r = 0; r < 16; ++r) X[(d0 * 16 + r) * 64 + lane] = o[d0][r] * rli[r] * lam;
    }
    asm volatile("s_waitcnt lgkmcnt(0)" ::: "memory");
    __syncthreads();
    if (map == 0) {
      float ss[16];
#pragma unroll
      for (int r = 0; r < 16; ++r) ss[r] = 0.f;
#pragma unroll
      for (int d0 = 0; d0 < 4; ++d0)
#pragma unroll
        for (int r = 0; r < 16; ++r) { const float d = o[d0][r] * rli[r] - X[(d0 * 16 + r) * 64 + lane]; o[d0][r] = d; ss[r] += d * d; }
#pragma unroll
      for (int r = 0; r < 16; ++r) {
#pragma unroll
        for (int s = 1; s < 32; s <<= 1) ss[r] += __shfl_xor(ss[r], s);
        ss[r] = rsqrtf(ss[r] * (1.0f / 128.0f) + EPS) * osc; }
      float g[4];
#pragma unroll
      for (int d0 = 0; d0 < 4; ++d0) g[d0] = gvec[d0 * 32 + r32];
      LAS char* T = (LAS char*)X;
      ATT_STORE_TILE(T, o[d0][r] * ss[r] * g[d0]);
    }
  }
#undef TILE_K0
#undef DQ
#undef CLS
#undef QK
#undef QKM
#undef DMA
#undef DWAIT
#undef RESC
  return claimed;
}
}

constexpr size_t MiB = 1u << 20;
constexpr size_t WS_CTL = 0, CTL_ZERO_BYTES = MiB / 8;
constexpr size_t WS_ROWSS = 1 * MiB;
constexpr size_t WS_KVB = 4 * MiB;
constexpr size_t WS_WIN = 20 * MiB;
constexpr size_t WS_WOUT = 100 * MiB;
constexpr size_t WS_WUP = 132 * MiB;
constexpr size_t WS_WDN = 260 * MiB;
constexpr size_t WS_XB = 388 * MiB;
constexpr size_t WS_BIG = 516 * MiB;
constexpr size_t WS_HID = WS_BIG;
constexpr size_t WS_PROJ = WS_BIG;
constexpr size_t WS_MIX = WS_BIG + 320 * MiB;
constexpr size_t WS_WKV = WS_BIG + 448 * MiB;
constexpr size_t WS_KVRAW = WS_BIG + 464 * MiB;
constexpr size_t WS_MEMB = WS_BIG + 496 * MiB;
constexpr size_t WS_END = WS_BIG + 512 * MiB;
static_assert((size_t)2 * MCH * DFF * 2 <= 320 * MiB, "two hidden chunks fit below MIX in the BIG region");
constexpr int CW_QUEUE = 16384;
constexpr int CW_BAR = 4096;
constexpr int LDS_BYTES = 163840;
constexpr int LDS_SCR = 131072;
constexpr int LDS_MISC = LDS_BYTES - 512;
constexpr int LDS_PTRS = LDS_BYTES - 256;
static_assert(att::ATT_LDS <= LDS_MISC && LDS_SCR + 4096 <= LDS_MISC && 64 * 516 * 4 <= LDS_MISC, "LDS map");

__device__ __forceinline__ void cvt_w_tile(const float* __restrict__ W, int K, int N, const float* __restrict__ g, bf16* __restrict__ WT, int kb, int nb, LAS float* scr, int tid, bool mapf) {
    const int k0 = kb * 64, n0 = nb * 512;
    { const int c4 = (tid & 127) * 4; f32x4 w[16]; float gg[16];
#pragma unroll
      for (int it = 0; it < 16; ++it) { const int kk = it * 4 + (tid >> 7); w[it] = *(const GAS f32x4*)(W + (size_t)(k0 + kk) * N + n0 + c4); gg[it] = g ? g[k0 + kk] : 1.f; }
#pragma unroll
      for (int it = 0; it < 16; ++it) { const int kk = it * 4 + (tid >> 7); *(LAS f32x4*)(scr + kk * 516 + c4) = w[it] * gg[it]; } }
    __syncthreads();
    const int s = tid & 255, pl = tid >> 8, col = pl * 256 + pg8::slot_col(s, mapf);
    bf16* dst = WT + (size_t)(n0 + pl * 256 + s) * K + k0;
#pragma unroll
    for (int c = 0; c < 8; ++c) { float f[8];
#pragma unroll
        for (int j = 0; j < 8; ++j) f[j] = scr[(8 * c + j) * 516 + col];
        *(GAS bf16x8*)(dst + 8 * c) = pack8(f); }
    __syncthreads();
}
__device__ __forceinline__ float row_to_bf16(const float* __restrict__ xrow, bf16* __restrict__ orow, bool normalise, int lane) {
    const GAS f32x4* xr = (const GAS f32x4*)xrow + lane;
    f32x4 v[8]; float s = 0.f;
#pragma unroll
    for (int j = 0; j < 8; ++j) { v[j] = xr[64 * j]; s += (v[j].x * v[j].x + v[j].y * v[j].y) + (v[j].z * v[j].z + v[j].w * v[j].w); }
    s = wave_sum(s);
    const float sc = normalise ? rsqrtf(s * (1.0f / DM) + EPS) : 1.f;
    GAS unsigned long long* o8 = (GAS unsigned long long*)orow + lane;
#pragma unroll
    for (int j = 0; j < 8; ++j) o8[64 * j] = (unsigned long long)pg8::cvt_pk_bf16(v[j].x * sc, v[j].y * sc) | ((unsigned long long)pg8::cvt_pk_bf16(v[j].z * sc, v[j].w * sc) << 32);
    return s;
}
__device__ __forceinline__ void kv_row(const float* __restrict__ src, bf16* __restrict__ dst, const float* __restrict__ gk, int lane) {
    const f32x4 a = *(const GAS f32x4*)(src + 8 * lane), b = *(const GAS f32x4*)(src + 8 * lane + 4);
    float ss = (a.x * a.x + a.y * a.y) + (a.z * a.z + a.w * a.w) + (b.x * b.x + b.y * b.y) + (b.z * b.z + b.w * b.w);
    ss += __shfl_xor(ss, 1); ss += __shfl_xor(ss, 2); ss += __shfl_xor(ss, 4); ss += __shfl_xor(ss, 8);
    const float rn = rsqrtf(ss * (1.0f / 128.0f) + EPS);
    const float* gp = gk + ((8 * lane) & 127);
    float f[8] = {a.x * rn * gp[0], a.y * rn * gp[1], a.z * rn * gp[2], a.w * rn * gp[3], b.x * rn * gp[4], b.y * rn * gp[5], b.z * rn * gp[6], b.w * rn * gp[7]};
    *(GAS bf16x8*)(dst + 8 * lane) = pack8(f);
    const f32x4 c = *(const GAS f32x4*)(src + 512 + 8 * lane), d = *(const GAS f32x4*)(src + 512 + 8 * lane + 4);
    float h[8] = {c.x, c.y, c.z, c.w, d.x, d.y, d.z, d.w};
    *(GAS bf16x8*)(dst + 512 + 8 * lane) = pack8(h);
}
__device__ __forceinline__ void load_gcu(const bf16* __restrict__ P, int row, int c0, float (&v)[8]) {
    const bf16x8 gc = *(const GAS bf16x8*)(P + (size_t)row * NIN + 3584 + c0), uu = *(const GAS bf16x8*)(P + (size_t)row * NIN + 4096 + c0);
#pragma unroll
    for (int i = 0; i < 8; ++i) v[i] = bf2f(gc[i]) * bf2f(uu[i]);
}
__device__ __forceinline__ void conv_rows16(const bf16* __restrict__ P, bf16* __restrict__ MIX, const float* __restrict__ cw, const float* __restrict__ gco, int row0, int lane) {
    const int c0 = lane * 8;
    float w0[8], w1[8], w2[8], g[8];
#pragma unroll
    for (int i = 0; i < 8; ++i) { w0[i] = cw[c0 + i]; w1[i] = cw[512 + c0 + i]; w2[i] = cw[1024 + c0 + i]; g[i] = gco[c0 + i]; }
    float vp[8], vc[8];
    if ((row0 & (SEQ - 1)) != 0) load_gcu(P, row0 - 1, c0, vp); else {
#pragma unroll
        for (int i = 0; i < 8; ++i) vp[i] = 0.f; }
    load_gcu(P, row0, c0, vc);
    bf16x8 gcn[2][4], un[2][4], gb[2][4];
#define CONV_LOAD(B, rb_) do { _Pragma("unroll") for (int k = 0; k < 4; ++k) { const int row = row0 + (rb_) + k; const int rn = ((row & (SEQ - 1)) != SEQ - 1) ? row + 1 : row;     \
            gcn[B][k] = *(const GAS bf16x8*)(P + (size_t)rn * NIN + 3584 + c0); un[B][k] = *(const GAS bf16x8*)(P + (size_t)rn * NIN + 4096 + c0); \
            gb[B][k] = *(const GAS bf16x8*)(P + (size_t)row * NIN + 3072 + c0); } } while (0)
#define CONV_WORK(B, rb_) do { _Pragma("unroll") for (int k = 0; k < 4; ++k) { const int row = row0 + (rb_) + k; const bool has_n = (row & (SEQ - 1)) != SEQ - 1; \
            float vn[8], c[8]; float ss = 0.f; \
            _Pragma("unroll") for (int i = 0; i < 8; ++i) { vn[i] = has_n ? bf2f(gcn[B][k][i]) * bf2f(un[B][k][i]) : 0.f; \
                const float y = w0[i] * vp[i] + w1[i] * vc[i] + w2[i] * vn[i]; c[i] = bf2f(gb[B][k][i]) * y; ss += c[i] * c[i]; } \
            ss += __shfl_xor(ss, 1); ss += __shfl_xor(ss, 2); ss += __shfl_xor(ss, 4); ss += __shfl_xor(ss, 8); \
            const float rn = rsqrtf(ss * (1.0f / 128.0f) + EPS); \
            _Pragma("unroll") for (int i = 0; i < 8; ++i) { c[i] = c[i] * rn * g[i]; vp[i] = vc[i]; vc[i] = vn[i]; } \
            *(GAS bf16x8*)(MIX + (size_t)row * DM + 1024 + c0) = pack8(c); } } while (0)
    CONV_LOAD(0, 0);
    CONV_LOAD(1, 4);  asm volatile("" ::: "memory"); CONV_WORK(0, 0);
    CONV_LOAD(0, 8);  asm volatile("" ::: "memory"); CONV_WORK(1, 4);
    CONV_LOAD(1, 12); asm volatile("" ::: "memory"); CONV_WORK(0, 8);
    CONV_WORK(1, 12);
#undef CONV_LOAD
#undef CONV_WORK
}

template <class T> __device__ __forceinline__ GAS T* opq(T* p) { GAS T* q = (GAS T*)p; asm volatile("" : "+s"(q)); return q; }
__device__ __forceinline__ const float* in_ptr(LAS unsigned char* lds, int i) {
    unsigned off = LDS_PTRS + 8 * i; asm volatile("" : "+v"(off));
    const unsigned lo = *(volatile LAS unsigned*)(lds + off), hi = *(volatile LAS unsigned*)(lds + off + 4);
    return (const float*)(const GAS float*)(uintptr_t)(((unsigned long long)(unsigned)__builtin_amdgcn_readfirstlane((int)hi) << 32) | (unsigned)__builtin_amdgcn_readfirstlane((int)lo));
}
struct Args { const float* in[21]; float* out; unsigned char* ws; int ph_lo, ph_hi; };
constexpr int PH_PER_LAYER = 4 + NCH, N_PHASES = 2 + DEPTH * PH_PER_LAYER;
__global__ void __launch_bounds__(512, 2) hybrid_fwd(Args args) {
    extern __shared__ __attribute__((aligned(16))) unsigned char lds_raw[];
    LAS unsigned char* lds = (LAS unsigned char*)lds_raw;
    volatile LAS unsigned* MISC = (volatile LAS unsigned*)(lds + LDS_MISC);
    const int tid0 = threadIdx.x, wave = __builtin_amdgcn_readfirstlane(tid0 >> 6);
    const int G = gridDim.x; const int bx = blockIdx.x; const int vcu = (G % 8 == 0) ? (bx % 8) * (G / 8) + bx / 8 : bx;
    unsigned char* ws0 = args.ws;
    if (tid0 < 64) MISC[tid0] = 0u;
    if (tid0 == 0) { LAS unsigned long long* pt = (LAS unsigned long long*)(lds + LDS_PTRS);
#define PUT(i) pt[i] = (unsigned long long)(uintptr_t)args.in[i]
        PUT(0); PUT(1); PUT(2); PUT(3); PUT(4); PUT(5); PUT(6); PUT(7); PUT(8); PUT(9); PUT(10); PUT(11); PUT(12); PUT(13); PUT(14); PUT(15); PUT(16); PUT(17); PUT(18); PUT(19); PUT(20);
#undef PUT
    }
    __syncthreads();
    XcdBarrier bar = xcd_barrier_post((unsigned*)(ws0 + WS_CTL) + CW_BAR, MISC + 8);
    float* out0 = args.out;
#define INP(i) in_ptr(lds, (i))
#define rowss ((float*)(GAS float*)(ws + WS_ROWSS))
#define KVB ((bf16*)(GAS bf16*)(ws + WS_KVB))
#define WIN ((bf16*)(GAS bf16*)(ws + WS_WIN))
#define WKV ((bf16*)(GAS bf16*)(ws + WS_WKV))
#define WOUT ((bf16*)(GAS bf16*)(ws + WS_WOUT))
#define WUP ((bf16*)(GAS bf16*)(ws + WS_WUP))
#define WDN ((bf16*)(GAS bf16*)(ws + WS_WDN))
#define XB ((bf16*)(GAS bf16*)(ws + WS_XB))
#define MIX ((bf16*)(GAS bf16*)(ws + WS_MIX))
#define KVRAW ((float*)(GAS float*)(ws + WS_KVRAW))
#define MEMB ((bf16*)(GAS bf16*)(ws + WS_MEMB))
#define PROJ ((bf16*)(GAS bf16*)(ws + WS_PROJ))
#define HID ((bf16*)(GAS bf16*)(ws + WS_HID))
    const int lo = args.ph_lo, hi = args.ph_hi;
#define IN(k) (lo <= (k) && (k) < hi)
#define SEAM(k) do { if (IN((k) + 1)) xcd_barrier(bar); } while (0)
    const int gw = vcu * 8 + wave, NGW = G * 8;

    if (IN(0)) {
            GAS unsigned char* ws = opq(ws0); float* out = (float*)opq(out0); (void)out; int tid = tid0; asm volatile("" : "+v"(tid)); const int lane = tid & 63; (void)lane;
        LAS float* scr = (LAS float*)lds;
        constexpr int T_IN = 32 * 10, T_KV = 32 * 2, T_OUT = 32 * 4, T_UP = 32 * 16, T_DN = 128 * 4, T_LAYER = T_IN + T_KV + T_OUT + T_UP + T_DN;
        for (int t = vcu; t < DEPTH * T_LAYER; t += G) {
            const int l = t / T_LAYER; int r = t % T_LAYER;
            if (r < T_IN) { cvt_w_tile(INP(3) + (size_t)l * DM * NIN, DM, NIN, INP(2) + l * DM, WIN + (size_t)l * NIN * DM, r / 10, r % 10, scr, tid, false); continue; } r -= T_IN;
            if (r < T_KV) { cvt_w_tile(INP(14) + (size_t)l * DM * NKV, DM, NKV, INP(13) + l * DM, WKV + (size_t)l * NKV * DM, r / 2, r % 2, scr, tid, true); continue; } r -= T_KV;
            if (r < T_OUT) { cvt_w_tile(INP(17) + (size_t)l * DM * DM, DM, DM, nullptr, WOUT + (size_t)l * DM * DM, r / 4, r % 4, scr, tid, false); continue; } r -= T_OUT;
            if (r < T_UP) { cvt_w_tile(INP(19) + (size_t)l * DM * DFF, DM, DFF, INP(18) + l * DM, WUP + (size_t)l * DFF * DM, r / 16, r % 16, scr, tid, false); continue; } r -= T_UP;
            cvt_w_tile(INP(20) + (size_t)l * DFF * DM, DFF, DM, nullptr, WDN + (size_t)l * DM * DFF, r / 4, r % 4, scr, tid, false);
        }
        for (int m = gw; m < MTOT; m += NGW) {
            const float s = row_to_bf16(INP(0) + (size_t)m * DM, XB + (size_t)m * DM, false, lane);
            if (lane < 8) rowss[(size_t)lane * MTOT + m] = lane == 0 ? s : 0.f;
        }
        for (int m = gw; m < MROWS; m += NGW) (void)row_to_bf16(INP(1) + (size_t)m * DM, MEMB + (size_t)m * DM, true, lane);
        SEAM(0);
    }
    if (IN(1)) {
            GAS unsigned char* ws = opq(ws0); float* out = (float*)opq(out0); (void)out; int tid = tid0; asm volatile("" : "+v"(tid)); const int lane = tid & 63; (void)lane;
        pg8::Gemm g{MEMB, WKV, MROWS, DEPTH * NKV, DM}; pg8::StaticOrder S; S.init(MROWS, DEPTH * NKV, G, bx);
        pg8::EpiF32 E{KVRAW, DEPTH * NKV};
        pg8::gemm_phase<pg8::EpiF32, pg8::StaticOrder, true, true>(lds, g, S, E);
        SEAM(1);
    }
    for (int l = 0; l < DEPTH; ++l) {
        const int pb = 2 + l * PH_PER_LAYER;
        if (IN(pb)) {
            GAS unsigned char* ws = opq(ws0); float* out = (float*)opq(out0); (void)out; int tid = tid0; asm volatile("" : "+v"(tid)); const int lane = tid & 63; (void)lane;
            if (l == 0) {
                for (int it = gw; it < DEPTH * MROWS; it += NGW) { const int ll = it / MROWS, row = it % MROWS;
                    kv_row(KVRAW + (size_t)row * (DEPTH * NKV) + ll * NKV, KVB + ((size_t)ll * MROWS + row) * NKV, INP(16) + ll * 128, lane); }
            }
            pg8::Gemm g{XB, WIN + (size_t)l * NIN * DM, MTOT, NIN, DM}; pg8::StaticOrder S; S.init(MTOT, NIN, G, bx);
            pg8::EpiA E{PROJ, rowss, INP(4) + l * 64, INP(5) + l * 64};
            pg8::gemm_phase<pg8::EpiA, pg8::StaticOrder, true, true>(lds, g, S, E);
            SEAM(pb);
        }
        if (IN(pb + 1)) {
            GAS unsigned char* ws = opq(ws0); float* out = (float*)opq(out0); (void)out; int tid = tid0; asm volatile("" : "+v"(tid)); const int lane = tid & 63; (void)lane;
            float lam, osc;
            { float a = INP(6)[l * 64 + lane] * INP(7)[l * 64 + lane], b = INP(8)[l * 64 + lane] * INP(9)[l * 64 + lane];
              a = wave_sum(a); b = wave_sum(b); const float li = 0.8f - 0.6f * expf(-0.3f * (float)l); lam = expf(a) - expf(b) + li; osc = 1.f - li;
              lam = __uint_as_float(__builtin_amdgcn_readfirstlane(__float_as_uint(lam))); osc = __uint_as_float(__builtin_amdgcn_readfirstlane(__float_as_uint(osc))); }
            for (int ch = gw; ch < MTOT / 16; ch += NGW) conv_rows16(PROJ, MIX, INP(11) + l * 1536, INP(12) + l * 512, ch * 16, lane);
            float smaxm;
            { const float* gq = INP(15) + l * 128; const float* gk = INP(16) + l * 128;
              float ma = fmaxf(fabsf(gq[lane]), fabsf(gq[64 + lane])), mb = fmaxf(fabsf(gk[lane]), fabsf(gk[64 + lane]));
#pragma unroll
              for (int o = 1; o < 64; o <<= 1) { ma = fmaxf(ma, __shfl_xor(ma, o)); mb = fmaxf(mb, __shfl_xor(mb, o)); }
              smaxm = 128.f * QSCALE_M * ma * mb * 1.02f;
              smaxm = __uint_as_float(__builtin_amdgcn_readfirstlane(__float_as_uint(smaxm))); }
            for (int k = vcu; k < BATCH * 4 * (SEQ / 256); k += G) { const int bhm = k >> 4, qt = k & 15, b = bhm >> 2, hm = bhm & 3;
                const size_t r0 = (size_t)b * SEQ + qt * 256; const bf16* kv = KVB + ((size_t)l * MROWS + b * MEMTOK) * NKV + hm * 128;
                att::attn_unit<1>((LAS char*)lds, PROJ + r0 * NIN + 4608 + hm * 128, NIN, kv, kv + 512, NKV, MEMTOK / 64, 0, 0, 0.f, 0,
                                  MIX + r0 * DM + 1536 + hm * 128, DM, INP(15) + l * 128, 0.f, 1.f, smaxm); }
            float smax2;
            { const float a = fabsf(INP(4)[l * 64 + lane]), b = fabsf(INP(5)[l * 64 + lane]); float ma = a, mb = b;
#pragma unroll
              for (int o = 1; o < 64; o <<= 1) { ma = fmaxf(ma, __shfl_xor(ma, o)); mb = fmaxf(mb, __shfl_xor(mb, o)); }
              smax2 = 64.f * QSCALE_D * ma * mb * 1.02f;
              smax2 = __uint_as_float(__builtin_amdgcn_readfirstlane(__float_as_uint(smax2))); }
            {
            gu32* qbase = (gu32*)(GAS unsigned*)(ws + WS_CTL) + CW_QUEUE + l * 8 * 64;
            volatile LAS unsigned* slot = (volatile LAS unsigned*)(lds + LDS_MISC) + 16;
            for (int qq = 0; qq < 8; ++qq) { const int q = (bx + qq) & 7;
                __syncthreads();
                if (tid == 0) slot[0] = __hip_atomic_fetch_add(qbase + q * 64, 1u, RLX_AGENT);
                __syncthreads();
                unsigned idx = slot[0];
                while (idx < 8u * (SEQ / 128)) {
                    const int b = q, h = 7 - (int)(idx >> 5), qt = (int)(idx & 31);
                    const float mh2 = exp2f(-(float)(h + 1)) * LOG2E;
                    const float d0f = ceilf((25.f + 2.f * smax2) / mh2);
                    const int d0 = d0f < 8192.f ? (int)d0f : 8192;
                    int tlo = (qt * 128 - d0) >> 6, thi = (qt * 128 + 127 + d0) >> 6;
                    tlo = tlo < 0 ? 0 : tlo; thi = thi > SEQ / 64 - 1 ? SEQ / 64 - 1 : thi;
                    if (((thi - tlo + 1) & 1) != 0) { if (tlo > 0) --tlo; else ++thi; }
                    const size_t r0 = (size_t)b * SEQ + qt * 128; const bf16* kb = PROJ + (size_t)b * SEQ * NIN + 1024 + h * 128;
                    const unsigned nx = att::attn_unit<0>((LAS char*)lds, PROJ + r0 * NIN + h * 128, NIN, kb, kb + 1024, NIN, thi - tlo + 1, qt * 2 - tlo, tlo, mh2, qt * 128,
                                      MIX + r0 * DM + h * 128, DM, INP(10) + l * 128, lam, osc, smax2, qbase + q * 64);
                    if (tid == 0) slot[0] = nx;
                    __syncthreads();
                    idx = slot[0];
                }
            }
            }
            SEAM(pb + 1);
        }
        if (IN(pb + 2)) {
            GAS unsigned char* ws = opq(ws0); float* out = (float*)opq(out0); (void)out; int tid = tid0; asm volatile("" : "+v"(tid)); const int lane = tid & 63; (void)lane;
            pg8::Gemm g{MIX, WOUT + (size_t)l * DM * DM, MTOT, DM, DM}; pg8::StaticOrder S; S.init(MTOT, DM, G, bx);
            if (l == 0) { pg8::EpiResB<true> E{XB, INP(0), out, rowss, 0, (LAS float*)(lds + LDS_SCR), 0};
                pg8::gemm_phase<pg8::EpiResB<true>, pg8::StaticOrder, true, true>(lds, g, S, E); }
            else { pg8::EpiResB<false> E{XB, INP(0), out, rowss, 0, (LAS float*)(lds + LDS_SCR), 0};
                pg8::gemm_phase<pg8::EpiResB<false>, pg8::StaticOrder, true, true>(lds, g, S, E); }
            SEAM(pb + 2);
        }
        for (int c = 0; c <= NCH; ++c) {
            if (IN(pb + 3 + c)) {
            GAS unsigned char* ws = opq(ws0); float* out = (float*)opq(out0); (void)out; int tid = tid0; asm volatile("" : "+v"(tid)); const int lane = tid & 63; (void)lane;
                if (c > 0) { const int m0 = (c - 1) * MCH;
                    pg8::Gemm g{HID + (size_t)((c - 1) & 1) * MCH * DFF, WDN + (size_t)l * DM * DFF, MCH, DM, DFF}; pg8::StaticOrder S; S.init(MCH, DM, G, bx);
                    pg8::EpiResB<false> E{XB, INP(0), out, rowss, m0, (LAS float*)(lds + LDS_SCR), l == DEPTH - 1};
                    pg8::gemm_phase<pg8::EpiResB<false>, pg8::StaticOrder, true, true>(lds, g, S, E); }
                if (c < NCH) { const int m0 = c * MCH;
                    pg8::Gemm g{XB + (size_t)m0 * DM, WUP + (size_t)l * DFF * DM, MCH, DFF, DM}; pg8::StaticOrder S; S.init(MCH, DFF, G, bx);
                    pg8::EpiRelu2 E{HID + (size_t)(c & 1) * MCH * DFF, rowss, m0};
                    pg8::gemm_phase<pg8::EpiRelu2, pg8::StaticOrder, true, true>(lds, g, S, E); }
                SEAM(pb + 3 + c);
            }
        }
    }
#undef IN
#undef SEAM
#undef INP
#undef rowss
#undef KVB
#undef WIN
#undef WKV
#undef WOUT
#undef WUP
#undef WDN
#undef XB
#undef MIX
#undef KVRAW
#undef MEMB
#undef PROJ
#undef HID
}

#ifndef N_LAUNCHES
#define N_LAUNCHES 1
#endif
extern "C" void kernel_launch(void* const* d_in, const int* in_sizes, int n_in, void* d_out, int out_size, void* d_ws, size_t ws_size, hipStream_t stream) {
    static int grid = 0;
    if (grid == 0) {
        if (n_in != 21 || in_sizes[0] != MTOT * DM || out_size != MTOT * DM || ws_size < WS_END) {
            fprintf(stderr, "kernel_launch: shape/workspace mismatch: n_in %d in0 %d out %d ws %zu (need %zu)\n", n_in, n_in > 0 ? in_sizes[0] : -1, out_size, ws_size, (size_t)WS_END); grid = -1; return; }
        int dev = 0, cus = 0, per_cu = 0;
        if (hipGetDevice(&dev) != hipSuccess || hipDeviceGetAttribute(&cus, hipDeviceAttributeMultiprocessorCount, dev) != hipSuccess) { grid = -1; return; }
        if (hipFuncSetAttribute((const void*)hybrid_fwd, hipFuncAttributeMaxDynamicSharedMemorySize, LDS_BYTES) != hipSuccess) { fprintf(stderr, "kernel_launch: hipFuncSetAttribute failed\n"); grid = -1; return; }
        if (hipOccupancyMaxActiveBlocksPerMultiprocessor(&per_cu, (const void*)hybrid_fwd, 512, LDS_BYTES) != hipSuccess || per_cu < 1)
            fprintf(stderr, "kernel_launch: note: occupancy query reports %d workgroups per CU\n", per_cu);
        (void)hipGetLastError();
        grid = cus;
    }
    if (grid < 0) return;
    Args a{};
    for (int i = 0; i < 21; ++i) a.in[i] = (const float*)d_in[i];
    a.out = (float*)d_out; a.ws = (unsigned char*)d_ws;
#if N_LAUNCHES == 1
    if (hipMemsetAsync((char*)d_ws + WS_CTL, 0, CTL_ZERO_BYTES, stream) != hipSuccess) return;
    a.ph_lo = 0; a.ph_hi = N_PHASES;
    hipLaunchKernelGGL(hybrid_fwd, dim3(grid), dim3(512), LDS_BYTES, stream, a);
#else
    for (int p = 0; p < N_PHASES; ++p) {
        if (hipMemsetAsync((char*)d_ws + WS_CTL, 0, CTL_ZERO_BYTES, stream) != hipSuccess) return;
        a.ph_lo = p; a.ph_hi = p + 1;
        hipLaunchKernelGGL(hybrid_fwd, dim3(grid), dim3(512), LDS_BYTES, stream, a);
    }
#endif
    const hipError_t le = hipPeekAtLastError();
    if (le != hipSuccess) fprintf(stderr, "kernel_launch: launch failed: %s\n", hipGetErrorName(le));
}
```

```cpp
#include <hip/hip_runtime.h>
#include <cstdio>
#include <cstdint>

constexpr int BATCH = 8, SEQ = 4096, DM = 2048, DEPTH = 4;
constexpr int MTOT = BATCH * SEQ;
constexpr int NIN = 5120, DFF = 8192, NKV = 1024, MEMTOK = 256, MROWS = BATCH * MEMTOK;
constexpr float EPS = 1e-6f;
constexpr float LOG2E = 1.4426950408889634f;
constexpr float QSCALE_D = 0.125f * LOG2E;
constexpr float QSCALE_M = 0.08838834764831845f * LOG2E;
#ifndef NCH
#define NCH 4
#endif
constexpr int MCH = MTOT / NCH;

namespace pg8 {
#define PG8_LAS __attribute__((address_space(3)))
typedef unsigned short bf16_t;
typedef short bf16x8 __attribute__((ext_vector_type(8)));
typedef float f32x4 __attribute__((ext_vector_type(4)));
typedef unsigned u32x4 __attribute__((ext_vector_type(4)));
constexpr int BM = 256, BK = 64, HALF = 128, HTB = HALF * BK * 2  , STAGE_BYTES = 8 * HTB, NXCD = 8, WGM = 8;

__host__ __device__ __forceinline__ int lds_byte(int r, int c) { const int st = (r >> 4) * 2 + (c >> 5), rr = r & 15, cc = c & 31, ob = rr * 64 + cc * 2; return st * 1024 + (ob ^ (((ob >> 9) & 1) << 5)); }
__host__ __device__ __forceinline__ void stage_rc(int b, int& R, int& C) { const int st = b / 1024, sb = b % 1024, swz = sb ^ (((sb >> 9) & 1) << 5); R = (st >> 1) * 16 + swz / 64; C = (st & 1) * 32 + (swz % 64) / 2; }
__host__ __device__ __forceinline__ int perm32(int rho) { const int n = rho >> 4, i = rho & 15; return 8 * (i >> 2) + 4 * n + (i & 3); }

struct Unit { int pm, pn; };
struct Gemm { const bf16_t* A; const bf16_t* Bt; int M, N, K; };

struct StaticOrder {
    int nM, nN, nwg, G, c;
    __host__ __device__ void init(int M, int N, int G_, int c_) { nM = M / BM; nN = N / BM; nwg = nM * nN; G = G_; c = c_; }
    __host__ __device__ bool next(int i, Unit& u) const {
        const long L = (long)i * G + c; if (L >= nwg) return false;
        int wgid = (int)L; { const int q = nwg / NXCD, r = nwg % NXCD, xcd = wgid % NXCD, off = wgid / NXCD; wgid = (xcd < r ? xcd * (q + 1) : r * (q + 1) + (xcd - r) * q) + off; }
        const int nig = WGM * nN, gid = wgid / nig, fm = gid * WGM, gsz = (nM - fm) < WGM ? (nM - fm) : WGM;
        u.pm = fm + ((wgid % nig) % gsz); u.pn = (wgid % nig) / gsz; return true;
    }
    __device__ __forceinline__ void a_ready(const Unit&) const {}
    __device__ __forceinline__ void done(const Unit&) const {}
};

typedef __bf16 bf16x2_t __attribute__((ext_vector_type(2)));
typedef float f32x2_t __attribute__((ext_vector_type(2)));
__device__ __forceinline__ unsigned cvt_pk_bf16(float lo, float hi) { const f32x2_t v = {lo, hi}; return __builtin_bit_cast(unsigned, __builtin_convertvector(v, bf16x2_t)); }
template <class Epi, class Sched, bool ALIGN_EPI = false, bool SP2 = false>
__device__ __forceinline__ void gemm_phase(PG8_LAS unsigned char* lds, const Gemm g, const Sched& S, const Epi& E) {
    int tid_ = threadIdx.x; asm volatile("" : "+v"(tid_));
    const int tid = tid_, wid = __builtin_amdgcn_readfirstlane(tid >> 6), lane = tid & 63, wr = wid >> 2, wc = wid & 3, fr = lane & 15, fq = lane >> 4;
    const int K = g.K, nt = K / BK;
    unsigned voffA[2], voffB[2];
#pragma unroll
    for (int i = 0; i < 2; ++i) { int R, C; stage_rc(tid * 16 + i * 8192, R, C); const int Rb = Epi::PERM ? ((R & ~31) + perm32(R & 31)) : R;
        voffA[i] = (unsigned)(R * K + C) * 2u; voffB[i] = (unsigned)(Rb * K + C) * 2u; }
    const size_t kstep = (size_t)(BK * 2);
    const size_t hstep = (size_t)HALF * K * 2;
    const size_t tstep = 2 * hstep;
    const unsigned ldsw = (unsigned)wid * 1024u;
    const int aoff = lds_byte(wr * 64 + fr, fq * 8), boff = lds_byte(wc * 32 + fr, fq * 8);
#define PG8_SA(b, h) (((b) * 2 + (h)) * HTB)
#define PG8_SB(b, h) ((4 + (b) * 2 + (h)) * HTB)
#define PG8_STAGE(bufoff, gbase, voff) do { _Pragma("unroll") for (int _i = 0; _i < 2; ++_i) \
        __builtin_amdgcn_global_load_lds((const unsigned*)((const char*)(gbase) + (voff)[_i]), (PG8_LAS unsigned*)(lds + (bufoff) + ldsw + _i * 8192), 16, 0, 0); } while (0)
#define PG8_LDA(dst, b, h) do { _Pragma("unroll") for (int m = 0; m < 4; ++m) _Pragma("unroll") for (int k = 0; k < 2; ++k) dst[m][k] = *(const PG8_LAS bf16x8*)(lds + PG8_SA(b, h) + aoff + m * 2048 + k * 1024); } while (0)
#define PG8_LDB(dst, b, h) do { _Pragma("unroll") for (int n = 0; n < 2; ++n) _Pragma("unroll") for (int k = 0; k < 2; ++k) dst[n][k] = *(const PG8_LAS bf16x8*)(lds + PG8_SB(b, h) + boff + n * 2048 + k * 1024); } while (0)
#define PG8_MMA(ai, bj, At, Bt) do { __builtin_amdgcn_s_setprio(1); _Pragma("unroll") for (int m = 0; m < 4; ++m) _Pragma("unroll") for (int n = 0; n < 2; ++n) _Pragma("unroll") for (int k = 0; k < 2; ++k) \
        acc[ai][bj][m][n] = __builtin_amdgcn_mfma_f32_16x16x32_bf16(Bt[n][k], At[m][k], acc[ai][bj][m][n], 0, 0, 0); __builtin_amdgcn_s_setprio(0); } while (0)
#define PG8_WAIT_V(n) asm volatile("s_waitcnt vmcnt(" #n ")" ::: "memory")
#define PG8_WAIT_L(n) asm volatile("s_waitcnt lgkmcnt(" #n ")" ::: "memory")
#define PG8_BAR __builtin_amdgcn_s_barrier()
#define PG8_SCHED __builtin_amdgcn_sched_barrier(0)
    Unit cur, nxt; int ui = 0;
    if (!S.next(0, cur)) return;
    f32x4 acc[2][2][4][2];
#pragma unroll
    for (int a = 0; a < 2; ++a)
#pragma unroll
        for (int b = 0; b < 2; ++b)
#pragma unroll
            for (int m = 0; m < 4; ++m)
#pragma unroll
                for (int n = 0; n < 2; ++n) acc[a][b][m][n] = (f32x4){0.f, 0.f, 0.f, 0.f};
    bf16x8 At[4][2], B0[2][2], B1[2][2];
    const char* cA = (const char*)g.A + (size_t)cur.pm * tstep; const char* cB = (const char*)g.Bt + (size_t)cur.pn * tstep;
    S.a_ready(cur);
    if constexpr (SP2) {
        PG8_STAGE(PG8_SB(0, 0), cB, voffB); PG8_STAGE(PG8_SB(0, 1), cB + hstep, voffB); PG8_STAGE(PG8_SA(0, 0), cA, voffA); PG8_STAGE(PG8_SA(0, 1), cA + hstep, voffA);
        if (wr == 1) PG8_BAR;
        PG8_WAIT_V(2); PG8_BAR;
        PG8_STAGE(PG8_SB(1, 0), cB + kstep, voffB); PG8_STAGE(PG8_SA(1, 0), cA + kstep, voffA); PG8_STAGE(PG8_SB(1, 1), cB + hstep + kstep, voffB);
        PG8_WAIT_V(6); PG8_BAR;
    } else {
        PG8_STAGE(PG8_SB(0, 0), cB, voffB); PG8_STAGE(PG8_SA(0, 0), cA, voffA); PG8_STAGE(PG8_SB(0, 1), cB + hstep, voffB); PG8_STAGE(PG8_SA(0, 1), cA + hstep, voffA);
        if (wr == 1) PG8_BAR;
        PG8_WAIT_V(4); PG8_BAR;
        PG8_STAGE(PG8_SB(1, 0), cB + kstep, voffB); PG8_STAGE(PG8_SA(1, 0), cA + kstep, voffA); PG8_STAGE(PG8_SB(1, 1), cB + hstep + kstep, voffB);
        PG8_WAIT_V(6); PG8_BAR;
    }
    for (;;) {
        const bool has_next = S.next(ui + 1, nxt);
        const char* nA = has_next ? (const char*)g.A + (size_t)nxt.pm * tstep : cA; const char* nB = has_next ? (const char*)g.Bt + (size_t)nxt.pn * tstep : cB;
        for (int t = 0; t < nt; t += 2) {
            const bool last = (t == nt - 2);
            const char* a1 = cA + (size_t)(t + 1) * kstep;
            const char* a2 = last ? nA : cA + (size_t)(t + 2) * kstep; const char* b2 = last ? nB : cB + (size_t)(t + 2) * kstep;
            const char* a3 = a2 + kstep; const char* b3 = b2 + kstep;
            if (last && has_next) S.a_ready(nxt);
            if constexpr (SP2) {
            PG8_LDB(B0, 0, 0); PG8_LDB(B1, 0, 1); PG8_SCHED; PG8_LDA(At, 0, 0); PG8_STAGE(PG8_SA(1, 1), a1 + hstep, voffA);
            PG8_WAIT_V(8); PG8_WAIT_L(0); PG8_BAR; PG8_MMA(0, 0, At, B0); PG8_MMA(0, 1, At, B1); PG8_BAR; PG8_SCHED;
            PG8_LDA(At, 0, 1); PG8_STAGE(PG8_SB(0, 0), b2, voffB); PG8_STAGE(PG8_SB(0, 1), b2 + hstep, voffB); PG8_STAGE(PG8_SA(0, 0), a2, voffA);
            PG8_WAIT_V(8); PG8_WAIT_L(0); PG8_BAR; PG8_MMA(1, 0, At, B0); PG8_MMA(1, 1, At, B1); PG8_BAR; PG8_SCHED;
            PG8_LDB(B0, 1, 0); PG8_LDB(B1, 1, 1); PG8_SCHED; PG8_LDA(At, 1, 0); PG8_STAGE(PG8_SA(0, 1), a2 + hstep, voffA);
            PG8_WAIT_V(8); PG8_WAIT_L(0); PG8_BAR; PG8_MMA(0, 0, At, B0); PG8_MMA(0, 1, At, B1); PG8_BAR; PG8_SCHED;
            PG8_LDA(At, 1, 1); PG8_STAGE(PG8_SB(1, 0), b3, voffB); PG8_STAGE(PG8_SB(1, 1), b3 + hstep, voffB); PG8_STAGE(PG8_SA(1, 0), a3, voffA);
            PG8_WAIT_V(8); PG8_WAIT_L(0); PG8_BAR; PG8_MMA(1, 0, At, B0); PG8_MMA(1, 1, At, B1); PG8_BAR; PG8_SCHED;
            } else {
            PG8_LDB(B0, 0, 0); PG8_SCHED; PG8_LDA(At, 0, 0); PG8_STAGE(PG8_SA(1, 1), a1 + hstep, voffA);
            PG8_WAIT_L(8); PG8_BAR; PG8_WAIT_L(0); PG8_MMA(0, 0, At, B0); PG8_BAR; PG8_SCHED;
            PG8_LDB(B1, 0, 1); PG8_STAGE(PG8_SB(0, 0), b2, voffB);
            PG8_BAR; PG8_WAIT_L(0); PG8_MMA(0, 1, At, B1); PG8_BAR;
            PG8_LDA(At, 0, 1); PG8_STAGE(PG8_SA(0, 0), a2, voffA);
            PG8_BAR; PG8_WAIT_L(0); PG8_MMA(1, 0, At, B0); PG8_BAR; PG8_SCHED;
            PG8_STAGE(PG8_SB(0, 1), b2 + hstep, voffB);
            PG8_WAIT_V(6); PG8_BAR; PG8_MMA(1, 1, At, B1); PG8_BAR;
            PG8_LDB(B0, 1, 0); PG8_SCHED; PG8_LDA(At, 1, 0); PG8_STAGE(PG8_SA(0, 1), a2 + hstep, voffA);
            PG8_WAIT_L(8); PG8_BAR; PG8_WAIT_L(0); PG8_MMA(0, 0, At, B0); PG8_BAR; PG8_SCHED;
            PG8_LDB(B1, 1, 1); PG8_STAGE(PG8_SB(1, 0), b3, voffB);
            PG8_BAR; PG8_WAIT_L(0); PG8_MMA(0, 1, At, B1); PG8_BAR;
            PG8_LDA(At, 1, 1); PG8_STAGE(PG8_SA(1, 0), a3, voffA);
            PG8_BAR; PG8_WAIT_L(0); PG8_MMA(1, 0, At, B0); PG8_BAR; PG8_SCHED;
            PG8_STAGE(PG8_SB(1, 1), b3 + hstep, voffB);
            PG8_WAIT_V(6); PG8_BAR; PG8_MMA(1, 1, At, B1); PG8_BAR;
            }
        }
        if constexpr (ALIGN_EPI) { if (wr == 0) PG8_BAR; }
        if constexpr (!Epi::AFTER_DRAIN) { E(acc, cur, wr, wc, fr, fq); S.done(cur); }
        if (!has_next) break;
#pragma unroll
        for (int a = 0; a < 2; ++a)
#pragma unroll
            for (int b = 0; b < 2; ++b)
#pragma unroll
                for (int m = 0; m < 4; ++m)
#pragma unroll
                    for (int n = 0; n < 2; ++n) acc[a][b][m][n] = (f32x4){0.f, 0.f, 0.f, 0.f};
        cur = nxt; cA = nA; cB = nB; ++ui;
        if constexpr (ALIGN_EPI) { if (wr == 1) PG8_BAR; }
    }
    PG8_WAIT_V(0);
    if constexpr (!ALIGN_EPI) { if (wr == 0) PG8_BAR; }
    PG8_BAR;
    if constexpr (Epi::AFTER_DRAIN) { E.fused(acc, cur, wr, wc, fr, fq, lds, wid, lane); S.done(cur); }
#undef PG8_SA
#undef PG8_SB
#undef PG8_STAGE
#undef PG8_LDA
#undef PG8_LDB
#undef PG8_MMA
#undef PG8_WAIT_V
#undef PG8_WAIT_L
#undef PG8_BAR
#undef PG8_SCHED
}
}

namespace pg8 {
typedef unsigned u32x2 __attribute__((ext_vector_type(2)));
__host__ __device__ __forceinline__ int slot_col(int s, bool mapf) { const int bj = s >> 7, wc = (s >> 5) & 3, n = (s >> 4) & 1, fq = (s >> 2) & 3, e = s & 3;
    return mapf ? 64 * wc + 32 * bj + 16 * n + 4 * fq + e : 64 * wc + 32 * bj + 8 * fq + 4 * n + e; }

__device__ __forceinline__ void load_rstd(const float* __restrict__ rowss, int grow0, float (&rs)[2][4], int lane, int fr) {
    float t[2][8];
#pragma unroll
    for (int ai = 0; ai < 2; ++ai)
#pragma unroll
        for (int k = 0; k < 8; ++k) t[ai][k] = rowss[(size_t)k * MTOT + grow0 + 128 * ai + lane];
#pragma unroll
    for (int ai = 0; ai < 2; ++ai) {
        const float s = ((t[ai][0] + t[ai][1]) + (t[ai][2] + t[ai][3])) + ((t[ai][4] + t[ai][5]) + (t[ai][6] + t[ai][7]));
        const float r = rsqrtf(s * (1.0f / DM) + EPS);
#pragma unroll
        for (int m = 0; m < 4; ++m) rs[ai][m] = __shfl(r, 16 * m + fr);
    }
}
__device__ __forceinline__ void st16(void* p, u32x4 v) { *(u32x4*)p = v; }
__device__ __forceinline__ void st16f(float* p, f32x4 v) { st16((void*)p, __builtin_bit_cast(u32x4, v)); }
__device__ __forceinline__ float fq_sum(float v) {
    auto a = __builtin_amdgcn_permlane16_swap(__float_as_uint(v), __float_as_uint(v), false, false); const float s = __uint_as_float(a[0]) + __uint_as_float(a[1]);
    auto b = __builtin_amdgcn_permlane32_swap(__float_as_uint(s), __float_as_uint(s), false, false); return __uint_as_float(b[0]) + __uint_as_float(b[1]);
}
__device__ __forceinline__ u32x4 pack_bf16_8(const float (&v)[8]) {
    u32x4 w; w.x = cvt_pk_bf16(v[0], v[1]); w.y = cvt_pk_bf16(v[2], v[3]); w.z = cvt_pk_bf16(v[4], v[5]); w.w = cvt_pk_bf16(v[6], v[7]); return w;
}

struct EpiA {
    static constexpr bool PERM = false, AFTER_DRAIN = false;
    bf16_t* P; const float* rowss; const float* gq; const float* gk;
    __device__ __forceinline__ void operator()(const f32x4 (&acc)[2][2][4][2], const Unit& u, int wr, int wc, int fr, int fq) const {
        const int lane = fr + 16 * fq; const int rbase = u.pm * BM + wr * 64;
        float rs[2][4]; load_rstd(rowss, rbase, rs, lane, fr);
        const int col0 = u.pn * BM + wc * 64 + 8 * fq;
        const int mode = u.pn < 4 ? 1 : (u.pn < 8 ? 2 : 0);
        float g[2][8];
        if (mode) { const float* gp = (mode == 1 ? gq : gk) + 8 * fq; const float sc = (mode == 1) ? QSCALE_D : 1.0f;
#pragma unroll
            for (int bj = 0; bj < 2; ++bj)
#pragma unroll
                for (int i = 0; i < 8; ++i) g[bj][i] = gp[32 * bj + i] * sc; }
        else {
#pragma unroll
            for (int bj = 0; bj < 2; ++bj)
#pragma unroll
                for (int i = 0; i < 8; ++i) g[bj][i] = 1.f; }
#pragma unroll
        for (int ai = 0; ai < 2; ++ai)
#pragma unroll
            for (int m = 0; m < 4; ++m) {
                float v[2][8]; const float r = rs[ai][m];
#pragma unroll
                for (int bj = 0; bj < 2; ++bj)
#pragma unroll
                    for (int n = 0; n < 2; ++n)
#pragma unroll
                        for (int e = 0; e < 4; ++e) v[bj][4 * n + e] = acc[ai][bj][m][n][e] * r;
                if (mode) {
                    float ss = 0.f;
#pragma unroll
                    for (int bj = 0; bj < 2; ++bj)
#pragma unroll
                        for (int i = 0; i < 8; ++i) ss += v[bj][i] * v[bj][i];
                    ss = fq_sum(ss);
                    const float rn = rsqrtf(ss * (1.0f / 64.0f) + EPS);
#pragma unroll
                    for (int bj = 0; bj < 2; ++bj)
#pragma unroll
                        for (int i = 0; i < 8; ++i) v[bj][i] = v[bj][i] * rn * g[bj][i];
                }
                bf16_t* dst = P + (size_t)(rbase + ai * HALF + m * 16 + fr) * NIN + col0;
                st16(dst, pack_bf16_8(v[0])); st16(dst + 32, pack_bf16_8(v[1]));
                asm volatile("" ::: "memory");
            }
    }
};
struct EpiRelu2 {
    static constexpr bool PERM = false, AFTER_DRAIN = false;
    bf16_t* H; const float* rowss; int m0;
    __device__ __forceinline__ void operator()(const f32x4 (&acc)[2][2][4][2], const Unit& u, int wr, int wc, int fr, int fq) const {
        const int lane = fr + 16 * fq; const int rbase = u.pm * BM + wr * 64;
        float rs[2][4]; load_rstd(rowss, m0 + rbase, rs, lane, fr);
        const int col0 = u.pn * BM + wc * 64 + 8 * fq;
#pragma unroll
        for (int ai = 0; ai < 2; ++ai)
#pragma unroll
            for (int m = 0; m < 4; ++m) {
                float v[2][8]; const float r = rs[ai][m];
#pragma unroll
                for (int bj = 0; bj < 2; ++bj)
#pragma unroll
                    for (int n = 0; n < 2; ++n)
#pragma unroll
                        for (int e = 0; e < 4; ++e) { const float t = fmaxf(acc[ai][bj][m][n][e] * r, 0.f); v[bj][4 * n + e] = t * t; }
                bf16_t* dst = H + (size_t)(rbase + ai * HALF + m * 16 + fr) * DFF + col0;
                st16(dst, pack_bf16_8(v[0])); st16(dst + 32, pack_bf16_8(v[1]));
                asm volatile("" ::: "memory");
            }
    }
};
template <bool FIRST>
struct EpiResB {
    static constexpr bool PERM = false, AFTER_DRAIN = false;
    bf16_t* XB; const float* x0f; float* outf; float* rowss; int m0; PG8_LAS float* scr; int final;
    __device__ __forceinline__ void operator()(const f32x4 (&acc)[2][2][4][2], const Unit& u, int wr, int wc, int fr, int fq) const {
        const int rbase = m0 + u.pm * BM + wr * 64; const int col0 = u.pn * BM + wc * 64 + 8 * fq;
        u32x4 raw[2][4][2];
        if constexpr (!FIRST) {
#pragma unroll
            for (int ai = 0; ai < 2; ++ai)
#pragma unroll
                for (int m = 0; m < 4; ++m) { const bf16_t* src = XB + (size_t)(rbase + ai * HALF + m * 16 + fr) * DM + col0;
#pragma unroll
                    for (int bj = 0; bj < 2; ++bj) raw[ai][m][bj] = *(const u32x4*)(src + 32 * bj); }
        }
#pragma unroll
        for (int ai = 0; ai < 2; ++ai) {
            f32x4 xf[4][2][2];
            if constexpr (FIRST) {
#pragma unroll
                for (int m = 0; m < 4; ++m) { const float* src = x0f + (size_t)(rbase + ai * HALF + m * 16 + fr) * DM + col0;
#pragma unroll
                    for (int bj = 0; bj < 2; ++bj) { xf[m][bj][0] = *(const f32x4*)(src + 32 * bj); xf[m][bj][1] = *(const f32x4*)(src + 32 * bj + 4); } }
            }
#pragma unroll
            for (int m = 0; m < 4; ++m) {
                const size_t roff = (size_t)(rbase + ai * HALF + m * 16 + fr) * DM + col0;
                float ss = 0.f;
#pragma unroll
                for (int bj = 0; bj < 2; ++bj) {
                    float xo[8];
                    if constexpr (FIRST) {
#pragma unroll
                        for (int k = 0; k < 4; ++k) { xo[k] = xf[m][bj][0][k]; xo[4 + k] = xf[m][bj][1][k]; }
                    } else {
#pragma unroll
                        for (int k = 0; k < 4; ++k) { const unsigned w = raw[ai][m][bj][k]; xo[2 * k] = __uint_as_float(w << 16); xo[2 * k + 1] = __uint_as_float(w & 0xffff0000u); }
                    }
                    float v[8];
#pragma unroll
                    for (int n = 0; n < 2; ++n)
#pragma unroll
                        for (int e = 0; e < 4; ++e) { const float t = acc[ai][bj][m][n][e] + xo[4 * n + e]; v[4 * n + e] = t; ss += t * t; }
                    if (final) { st16f(outf + roff + 32 * bj, (f32x4){v[0], v[1], v[2], v[3]}); st16f(outf + roff + 32 * bj + 4, (f32x4){v[4], v[5], v[6], v[7]}); }
                    else st16(XB + roff + 32 * bj, pack_bf16_8(v));
                }
                ss = fq_sum(ss);
                if (fq == 0) scr[wc * 256 + ai * HALF + wr * 64 + m * 16 + fr] = ss;
            }
            asm volatile("" ::: "memory");
        }
        asm volatile("s_waitcnt lgkmcnt(0)" ::: "memory"); __builtin_amdgcn_s_barrier(); asm volatile("" ::: "memory");
        int tid = threadIdx.x; asm volatile("" : "+v"(tid));
        if (tid < 256) rowss[(size_t)u.pn * MTOT + m0 + u.pm * BM + tid] = (scr[tid] + scr[256 + tid]) + (scr[512 + tid] + scr[768 + tid]);
    }
};
struct EpiF32 {
    static constexpr bool PERM = false, AFTER_DRAIN = false;
    float* O; int ldc;
    __device__ __forceinline__ void operator()(const f32x4 (&acc)[2][2][4][2], const Unit& u, int wr, int wc, int fr, int fq) const {
        const int rbase = u.pm * BM + wr * 64; const int col0 = u.pn * BM + wc * 64 + 4 * fq;
#pragma unroll
        for (int ai = 0; ai < 2; ++ai)
#pragma unroll
            for (int m = 0; m < 4; ++m) { float* rowp = O + (size_t)(rbase + ai * HALF + m * 16 + fr) * ldc + col0;
#pragma unroll
                for (int bj = 0; bj < 2; ++bj)
#pragma unroll
                    for (int n = 0; n < 2; ++n) *(f32x4*)(rowp + 32 * bj + 16 * n) = acc[ai][bj][m][n]; }
    }
};
}

#define GAS __attribute__((address_space(1)))
#define LAS __attribute__((address_space(3)))
typedef unsigned short bf16;
typedef unsigned v4u __attribute__((ext_vector_type(4)));
typedef float f32x4 __attribute__((ext_vector_type(4)));
typedef short bf16x8 __attribute__((ext_vector_type(8)));
typedef GAS unsigned gu32;
typedef GAS unsigned long long gu64;
#define RLX_AGENT __ATOMIC_RELAXED, __HIP_MEMORY_SCOPE_AGENT
#define LDS_WAIT() asm volatile("s_waitcnt lgkmcnt(0)" ::: "memory")
#define VM_WAIT() asm volatile("s_waitcnt vmcnt(0)" ::: "memory")
__device__ __forceinline__ unsigned long long rt() { return __builtin_amdgcn_s_memrealtime(); }
__device__ __forceinline__ unsigned f2bf(float f) { unsigned u = __builtin_bit_cast(unsigned, f); return (u + 0x7fffu + ((u >> 16) & 1u)) >> 16; }
__device__ __forceinline__ unsigned pk2(float lo, float hi) { return f2bf(lo) | (f2bf(hi) << 16); }

#define XB_TMO      128
#define XB_XCNT(j)  (256  + 64 * (j))
#define XB_XSUB(j)  (1280 + 64 * (j))
#define XB_XGEN(j)  (2304 + 64 * (j))
#define XB_TOP      3328
#define XB_TOPGEN   3392
#define XCD_BAR_WORDS 3456
#define XB_SPIN_CAP (1u << 18)

__device__ __forceinline__ unsigned xb_ld(unsigned* p)              { return __hip_atomic_load(p, __ATOMIC_RELAXED, __HIP_MEMORY_SCOPE_AGENT); }
__device__ __forceinline__ unsigned xb_add(unsigned* p, unsigned v) { return __hip_atomic_fetch_add(p, v, __ATOMIC_RELAXED, __HIP_MEMORY_SCOPE_AGENT); }
__device__ __forceinline__ unsigned xb_xcc_id() { return (unsigned)__builtin_amdgcn_s_getreg((3 << 11) | 20) & 0xFu; }
#define XB_SPIN(cond, bar) do { unsigned _sp = 0; while (cond) { __builtin_amdgcn_s_sleep(1); \
    if ((++_sp & 255u) == 0u) { if (xb_ld(&(bar)[XB_TMO])) break; if (_sp > XB_SPIN_CAP) { atomicAdd(&(bar)[XB_TMO], 1u); break; } } } } while (0)

struct XcdBarrier {
    unsigned* bar; unsigned x;
    volatile LAS unsigned* st;
};

__device__ __forceinline__ XcdBarrier xcd_barrier_post(unsigned* bar, volatile LAS unsigned* st) {
    XcdBarrier b; b.bar = bar; b.x = xb_xcc_id(); b.st = st;
    if (threadIdx.x == 0) (void)xb_add(&bar[XB_XCNT(b.x)], 1u);
    return b;
}
__device__ __forceinline__ void xcd_barrier_complete(unsigned* bar, unsigned x, unsigned& nloc, unsigned& nx) {
    const unsigned G = gridDim.x * gridDim.y * gridDim.z;
    unsigned sum, cnt, mine, sp = 0u;
    for (;;) {
        sum = 0u; cnt = 0u; mine = 0u;
#pragma unroll
        for (unsigned j = 0; j < 16; ++j) { const unsigned c = xb_ld(&bar[XB_XCNT(j)]); sum += c; cnt += (c > 0u) ? 1u : 0u; mine = (j == x) ? c : mine; }
        if (sum == G) break;
        __builtin_amdgcn_s_sleep(1);
        if ((++sp & 255u) == 0u) { if (xb_ld(&bar[XB_TMO])) break; if (sp > XB_SPIN_CAP) { atomicAdd(&bar[XB_TMO], 1u); break; } }
    }
    nloc = mine > 0u ? mine : 1u; nx = cnt > 0u ? cnt : 1u;
}

__device__ __forceinline__ void xcd_barrier(const XcdBarrier& b) {
    asm volatile("s_waitcnt vmcnt(0)" ::: "memory");
    __syncthreads();
    if (threadIdx.x == 0) {
        GAS unsigned* barg = (GAS unsigned*)b.bar; asm volatile("" : "+s"(barg)); unsigned* bar = (unsigned*)barg;
        __builtin_amdgcn_s_waitcnt(0);
        unsigned nloc = b.st[0], nx = b.st[1];
        if (nloc == 0u) { xcd_barrier_complete(bar, b.x, nloc, nx); b.st[0] = nloc; b.st[1] = nx; }
        const unsigned old = xb_add(&bar[XB_XSUB(b.x)], 1u);
        const unsigned gen = old / nloc;
        if (old + 1u == (gen + 1u) * nloc) {
            __builtin_amdgcn_fence(__ATOMIC_RELEASE, "agent");
            asm volatile("s_waitcnt vmcnt(0)" ::: "memory");
            const unsigned og = xb_add(&bar[XB_TOP], 1u);
            const unsigned tg = og / nx;
            if (og + 1u == (tg + 1u) * nx) xb_add(&bar[XB_TOPGEN], 1u);
            else XB_SPIN(xb_ld(&bar[XB_TOPGEN]) == tg, bar);
            __builtin_amdgcn_fence(__ATOMIC_ACQUIRE, "agent");
            xb_add(&bar[XB_XGEN(b.x)], 1u);
            asm volatile("s_waitcnt vmcnt(0)" ::: "memory");
        } else {
            XB_SPIN(xb_ld(&bar[XB_XGEN(b.x)]) == gen, bar);
            __builtin_amdgcn_fence(__ATOMIC_ACQUIRE, "agent");
            asm volatile("s_waitcnt vmcnt(0)" ::: "memory");
        }
    }
    __syncthreads();
}


__device__ __forceinline__ float wave_sum(float v) {
#pragma unroll
    for (int o = 1; o < 64; o <<= 1) v += __shfl_xor(v, o);
    return v;
}
__device__ __forceinline__ float bf2f(short s) { return __uint_as_float(((unsigned)(unsigned short)s) << 16); }
__device__ __forceinline__ bf16x8 pack8(const float (&f)[8]) {
    v4u w; w.x = pg8::cvt_pk_bf16(f[0], f[1]); w.y = pg8::cvt_pk_bf16(f[2], f[3]); w.z = pg8::cvt_pk_bf16(f[4], f[5]); w.w = pg8::cvt_pk_bf16(f[6], f[7]);
    return __builtin_bit_cast(bf16x8, w);
}

namespace att {
using s16x4  = __attribute__((ext_vector_type(4))) short;
using f32x16 = __attribute__((ext_vector_type(16))) float;
constexpr int KVBLK = 64;
constexpr int SHM_V = KVBLK * 128 * 2, SHM_K = KVBLK * 128 * 2;
constexpr int NBUF = 3;
constexpr int OFF_V = 0, OFF_K = NBUF * SHM_V, OFF_WS = NBUF * (SHM_V + SHM_K), OFF_X = 0  , ATT_LDS = OFF_WS + 8 * 64 * 4;
static_assert(4 * 4096 * 4 <= OFF_WS && 8 * 32 * 272 <= OFF_WS, "exchange buffer / output staging tiles fit the tile ring");
constexpr float THR2 = 8.f * LOG2E;
#define KSWZ(row, colB) ((row) * 256 + ((colB) ^ (((row) & 7) << 4)))
#define SBAR() __builtin_amdgcn_sched_barrier(0)
__device__ __forceinline__ int crow(int r, int hi) { return (r & 3) + 8 * (r >> 2) + 4 * hi; }

#define NOPK(x) asm("" : "+v"(x))
template <int MODE>
__device__ __forceinline__ void score_init(f32x16& p0, f32x16& p1, float m_reg, float mh2, float dq, int cls) {
  if constexpr (MODE == 0) {
    if (cls == 0) {
#pragma unroll
      for (int r = 0; r < 16; ++r) { const float c = (float)((r & 3) + 8 * (r >> 2));
        float a = fmaf(-mh2, fabsf(dq - c), -m_reg), b = fmaf(-mh2, fabsf(dq - (c + 32.f)), -m_reg); NOPK(a); NOPK(b); p0[r] = a; p1[r] = b; }
    } else {
      const float sm = cls > 0 ? mh2 : -mh2; const float base = fmaf(-sm, dq, -m_reg);
#pragma unroll
      for (int r = 0; r < 16; ++r) { const float c = (float)((r & 3) + 8 * (r >> 2));
        float a = fmaf(c, sm, base), b = fmaf(c + 32.f, sm, base); NOPK(a); NOPK(b); p0[r] = a; p1[r] = b; }
    }
  } else {
#pragma unroll
    for (int r = 0; r < 16; ++r) { p0[r] = -m_reg; p1[r] = -m_reg; }
  }
}
__device__ __forceinline__ void score_init_mono(f32x16& p0, f32x16& p1, float m_reg, float mh2, float dq, bool left) {
  const float sm = left ? mh2 : -mh2; const float base = fmaf(-sm, dq, -m_reg);
#pragma unroll
  for (int r = 0; r < 16; ++r) { const float c = (float)((r & 3) + 8 * (r >> 2));
    float a = fmaf(c, sm, base), b = fmaf(c + 32.f, sm, base); NOPK(a); NOPK(b); p0[r] = a; p1[r] = b; }
}
template <bool FIXED>
__device__ __forceinline__ void partialSM(f32x16& p0, f32x16& p1, float& m_reg, float& alpha) {
  if constexpr (FIXED) { alpha = 1.f;
#pragma unroll
    for (int r = 0; r < 16; ++r) p0[r] = __builtin_amdgcn_exp2f(p0[r]);
    return; }
  float pmax = p0[0];
#pragma unroll
  for (int r = 1; r < 16; ++r) pmax = fmaxf(pmax, p0[r]);
#pragma unroll
  for (int r = 0; r < 16; ++r) pmax = fmaxf(pmax, p1[r]);
  { auto rr = __builtin_amdgcn_permlane32_swap(__float_as_uint(pmax), __float_as_uint(pmax), false, false);
    pmax = fmaxf(__uint_as_float(rr[0]), __uint_as_float(rr[1])); }
  if (__builtin_expect(__all(pmax <= THR2), 1)) { alpha = 1.f; }
  else { const float d = fmaxf(pmax, 0.f); alpha = __builtin_amdgcn_exp2f(-d); m_reg += d;
#pragma unroll
    for (int r = 0; r < 16; ++r) { p0[r] = p0[r] - d; p1[r] = p1[r] - d; } }
#pragma unroll
  for (int r = 0; r < 16; ++r) p0[r] = __builtin_amdgcn_exp2f(p0[r]);
}
__device__ __forceinline__ void finishSM(f32x16& p0, f32x16& p1, float alpha, float& l_reg, bf16x8& pa0, bf16x8& pa1, bf16x8& pa2, bf16x8& pa3) {
#pragma unroll
  for (int r = 0; r < 16; ++r) p1[r] = __builtin_amdgcn_exp2f(p1[r]);
  float ps = 0;
#pragma unroll
  for (int r = 0; r < 16; ++r) ps += p0[r];
#pragma unroll
  for (int r = 0; r < 16; ++r) ps += p1[r];
  { auto rr = __builtin_amdgcn_permlane32_swap(__float_as_uint(ps), __float_as_uint(ps), false, false);
    ps = __uint_as_float(rr[0]) + __uint_as_float(rr[1]); }
  l_reg = l_reg * alpha + ps;
#define PK4(P, BASE, OUT) do { unsigned a0 = pg8::cvt_pk_bf16(P[BASE + 0], P[BASE + 1]), a1 = pg8::cvt_pk_bf16(P[BASE + 2], P[BASE + 3]);   \
    unsigned b0 = pg8::cvt_pk_bf16(P[BASE + 4], P[BASE + 5]), b1 = pg8::cvt_pk_bf16(P[BASE + 6], P[BASE + 7]);                              \
    auto r0 = __builtin_amdgcn_permlane32_swap(a0, b0, false, false); auto r1 = __builtin_amdgcn_permlane32_swap(a1, b1, false, false); \
    v4u w = {r0[0], r1[0], r0[1], r1[1]}; OUT = __builtin_bit_cast(bf16x8, w); } while (0)
  PK4(p0, 0, pa0); PK4(p0, 8, pa1); PK4(p1, 0, pa2); PK4(p1, 8, pa3);
#undef PK4
}
template <int ND0>
__device__ __forceinline__ void qkt(f32x16& p0, f32x16& p1, LAS const char* Ks, const bf16x8* qr, int r32, int hi, int dcol0) {
#pragma unroll
  for (int d0 = 0; d0 < ND0; ++d0) { const int cb = (dcol0 + d0 * 16 + hi * 8) * 2;
    const bf16x8 b0 = *(LAS const bf16x8*)(Ks + KSWZ(r32, cb));
    const bf16x8 b1 = *(LAS const bf16x8*)(Ks + KSWZ(32 + r32, cb));
    p0 = __builtin_amdgcn_mfma_f32_32x32x16_bf16(b0, qr[d0], p0, 0, 0, 0);
    p1 = __builtin_amdgcn_mfma_f32_32x32x16_bf16(b1, qr[d0], p1, 0, 0, 0); }
}
__device__ __forceinline__ void qkt_load4(bf16x8 (&kf)[4][2], LAS const char* Ks, int r32, int hi, int dcol0) {
#pragma unroll
  for (int d0 = 0; d0 < 4; ++d0) { const int cb = (dcol0 + d0 * 16 + hi * 8) * 2;
    kf[d0][0] = *(LAS const bf16x8*)(Ks + KSWZ(r32, cb)); kf[d0][1] = *(LAS const bf16x8*)(Ks + KSWZ(32 + r32, cb)); }
}
__device__ __forceinline__ void qkt_mma4(f32x16& p0, f32x16& p1, const bf16x8 (&kf)[4][2], const bf16x8* qr) {
#pragma unroll
  for (int d0 = 0; d0 < 4; ++d0) {
    p0 = __builtin_amdgcn_mfma_f32_32x32x16_bf16(kf[d0][0], qr[d0], p0, 0, 0, 0);
    p1 = __builtin_amdgcn_mfma_f32_32x32x16_bf16(kf[d0][1], qr[d0], p1, 0, 0, 0); }
}
__device__ __forceinline__ int v_st(int k, int c) { const int kk = (k & ~0xC) | ((k & 4) << 1) | ((k & 8) >> 1); return ((kk >> 3) * 4 + (c >> 5)) * 512 + ((kk & 7) * 32 + (c & 31)) * 2; }
__device__ __forceinline__ int v_rd_base(int lane) { return ((lane & 3) << 3) | (((lane >> 2) & 3) << 6) | (((lane >> 4) & 1) << 5) | (((lane >> 5) & 1) << 8); }
constexpr int v_rd_off(int d0, int ks, int half) { return d0 * 512 + ks * 4096 + half * 2048; }
typedef short v4i16_t __attribute__((ext_vector_type(4)));
template <int OFF> __device__ __forceinline__ s16x4 tr_read(int vb) {
  return __builtin_bit_cast(s16x4, __builtin_amdgcn_ds_read_tr16_b64_v4i16((LAS v4i16_t*)(uintptr_t)(unsigned)(vb + OFF)));
}
template <int D0> __device__ __forceinline__ void pv_one(f32x16& od, int vb, bf16x8 pa0, bf16x8 pa1, bf16x8 pa2, bf16x8 pa3) {
  const s16x4 l0 = tr_read<v_rd_off(D0, 0, 0)>(vb), h0 = tr_read<v_rd_off(D0, 0, 1)>(vb), l1 = tr_read<v_rd_off(D0, 1, 0)>(vb), h1 = tr_read<v_rd_off(D0, 1, 1)>(vb);
  const s16x4 l2 = tr_read<v_rd_off(D0, 2, 0)>(vb), h2 = tr_read<v_rd_off(D0, 2, 1)>(vb), l3 = tr_read<v_rd_off(D0, 3, 0)>(vb), h3 = tr_read<v_rd_off(D0, 3, 1)>(vb);
#define PK(L, H) (bf16x8){L[0], L[1], L[2], L[3], H[0], H[1], H[2], H[3]}
  od = __builtin_amdgcn_mfma_f32_32x32x16_bf16(pa0, PK(l0, h0), od, 0, 0, 0);
  od = __builtin_amdgcn_mfma_f32_32x32x16_bf16(pa1, PK(l1, h1), od, 0, 0, 0);
  od = __builtin_amdgcn_mfma_f32_32x32x16_bf16(pa2, PK(l2, h2), od, 0, 0, 0);
  od = __builtin_amdgcn_mfma_f32_32x32x16_bf16(pa3, PK(l3, h3), od, 0, 0, 0);
#undef PK
}
__device__ __forceinline__ void pv_d0(f32x16* o, int vb, bf16x8 pa0, bf16x8 pa1, bf16x8 pa2, bf16x8 pa3) {
  pv_one<0>(o[0], vb, pa0, pa1, pa2, pa3); pv_one<1>(o[1], vb, pa0, pa1, pa2, pa3); pv_one<2>(o[2], vb, pa0, pa1, pa2, pa3); pv_one<3>(o[3], vb, pa0, pa1, pa2, pa3);
}

constexpr int TPITCH = 272, TBYTES = 32 * TPITCH;
#define ATT_STORE_TILE(T, VAL) do { \
    _Pragma("unroll") for (int r = 0; r < 16; ++r) _Pragma("unroll") for (int d0 = 0; d0 < 4; ++d0) \
      *(LAS unsigned short*)((T) + crow(r, hi) * TPITCH + (d0 * 32 + r32) * 2) = (unsigned short)f2bf(VAL); \
    asm volatile("s_waitcnt lgkmcnt(0)" ::: "memory"); \
    _Pragma("unroll") for (int k = 0; k < 8; ++k) { const int c_ = lane + 64 * k, row_ = c_ >> 4, ch_ = c_ & 15; \
      const v4u w_ = *(LAS const v4u*)((T) + row_ * TPITCH + ch_ * 16); *(GAS v4u*)(Ow + (size_t)row_ * ldo + ch_ * 8) = w_; } } while (0)
__device__ __forceinline__ int tile_of(int i, int jd, int NT, int tlo) { int t = jd + i; t -= (t >= NT) ? NT : 0; return tlo + t; }
template <int MODE>
__device__ __forceinline__ void attn_unit(LAS char* lds, const bf16* __restrict__ Qb, int ldq, const bf16* __restrict__ Kh, const bf16* __restrict__ Vh, int ldk,
                                          int NT, int jd, int tlo, float mh2, int qpos0, bf16* __restrict__ Ob, int ldo, const float* __restrict__ gvec, float lam, float osc, float mfix = 0.f) {
  constexpr int ND0 = MODE == 0 ? 4 : 8;
  int tid_ = threadIdx.x; asm volatile("" : "+v"(tid_));
  const int tid = tid_, wid = __builtin_amdgcn_readfirstlane(tid >> 6), lane = tid & 63, r32 = lane & 31, hi = lane >> 5;
  const int map = MODE == 0 ? (wid >> 2) : 0, wq = MODE == 0 ? (wid & 3) : wid;
  LAS float* wsf = (LAS float*)(lds + OFF_WS) + wid * 64; LAS float* li_l = wsf; LAS float* al_l = wsf + 32;
  float m_reg = mfix, l_reg = 0; f32x16 o[4] = {}; bf16x8 qr[ND0];
  const bf16* Qw = Qb + (size_t)(wq * 32 + r32) * ldq + map * 64 + hi * 8;
  if constexpr (MODE == 0) {
#pragma unroll
    for (int d0 = 0; d0 < ND0; ++d0) qr[d0] = *(const bf16x8*)(Qw + d0 * 16);
  } else {
    float ss = 0.f;
#pragma unroll
    for (int d0 = 0; d0 < ND0; ++d0) { qr[d0] = *(const bf16x8*)(Qw + d0 * 16);
#pragma unroll
      for (int i = 0; i < 8; ++i) { const float f = bf2f(qr[d0][i]); ss += f * f; } }
    ss += __shfl_xor(ss, 32);
    const float rn = rsqrtf(ss * (1.0f / 128.0f) + EPS) * QSCALE_M;
#pragma unroll
    for (int d0 = 0; d0 < ND0; ++d0) { float f[8];
#pragma unroll
      for (int i = 0; i < 8; ++i) f[i] = bf2f(qr[d0][i]) * rn * gvec[d0 * 16 + hi * 8 + i];
      qr[d0] = pack8(f); }
  }
  const int vb0 = (int)(uintptr_t)(lds + OFF_V) + v_rd_base(lane);
  const float dqbase = (float)(qpos0 + wq * 32 + r32 - 4 * hi); const int qw0 = qpos0 + wq * 32;
  unsigned kofs[2], vofs[2];
#pragma unroll
  for (int q_ = 0; q_ < 2; ++q_) {
    const int krow = 8 * wid + 4 * q_ + (lane >> 4), kc = (lane & 15) ^ (krow & 7);
    kofs[q_] = (unsigned)krow * (unsigned)(ldk * 2) + (unsigned)kc * 16u;
    const int Q = (2 * wid + q_) * 64 + lane, st = Q >> 5, rr = Q & 31, kk = (st >> 2) * 8 + (rr >> 2), vc = (st & 3) * 32 + (rr & 3) * 8;
    const int vk = (kk & ~0xC) | ((kk & 4) << 1) | ((kk & 8) >> 1);
    vofs[q_] = (unsigned)vk * (unsigned)(ldk * 2) + (unsigned)vc * 2u;
  }
#define TILE_K0(i) (tile_of((i), jd, NT, tlo) * KVBLK)
#define DQ(i) (dqbase - (float)TILE_K0(i))
#define CLS(i) (TILE_K0(i) + 63 <= qw0 ? 1 : (TILE_K0(i) >= qw0 + 31 ? -1 : 0))
#define QK(P0, P1, KB, i) do { if constexpr (MODE == 0) { bf16x8 kf_[4][2]; qkt_load4(kf_, KB, r32, hi, map * 64); SBAR(); score_init<MODE>(P0, P1, m_reg, mh2, DQ(i), CLS(i)); qkt_mma4(P0, P1, kf_, qr); } \
    else { score_init<MODE>(P0, P1, m_reg, mh2, DQ(i), CLS(i)); qkt<ND0>(P0, P1, KB, qr, r32, hi, map * 64); } } while (0)
#define QKM(P0, P1, KB, i) do { bf16x8 kf_[4][2]; qkt_load4(kf_, KB, r32, hi, map * 64); SBAR(); score_init_mono(P0, P1, m_reg, mh2, DQ(i), TILE_K0(i) + 63 <= qw0); qkt_mma4(P0, P1, kf_, qr); } while (0)
#define DMA(slot, i) do { const size_t tb_ = (size_t)TILE_K0(i) * (size_t)(ldk * 2); \
    _Pragma("unroll") for (int q_ = 0; q_ < 2; ++q_) { \
      __builtin_amdgcn_global_load_lds((const unsigned*)((const char*)Kh + tb_ + kofs[q_]), (LAS unsigned*)(lds + OFF_K + (slot) * SHM_K + (2 * wid + q_) * 1024), 16, 0, 0); \
      __builtin_amdgcn_global_load_lds((const unsigned*)((const char*)Vh + tb_ + vofs[q_]), (LAS unsigned*)(lds + OFF_V + (slot) * SHM_V + (2 * wid + q_) * 1024), 16, 0, 0); } } while (0)
#define DWAIT() asm volatile("s_waitcnt vmcnt(0)" ::: "memory")
#define RESC(a) do { if (__any((a) < 1.f)) { if (hi == 0) al_l[r32] = (a); asm volatile("s_waitcnt lgkmcnt(0)" ::: "memory"); \
    _Pragma("unroll") for (int d = 0; d < 4; ++d) _Pragma("unroll") for (int r = 0; r < 16; ++r) o[d][r] *= al_l[crow(r, hi)]; } } while (0)
  f32x16 pA0, pA1, pB0, pB1; float alA, alB; bf16x8 pa0, pa1, pa2, pa3;
#define KB(b) (lds + OFF_K + (b) * SHM_K)
#define VB(b) (vb0 + (b) * SHM_V)
  int bp = 0, bq = 1, bw = 2;
  __syncthreads();
  DMA(0, 0); DMA(1, 1);
  DWAIT(); __syncthreads();
  if (wid >= 4) __builtin_amdgcn_s_setprio(1);
  QK(pA0, pA1, KB(0), 0); partialSM<true>(pA0, pA1, m_reg, alA);
#define BODY(QKX, QKY, j) do { \
    DMA(bw, (j) + 1);                                             \
    SBAR(); QKX(pB0, pB1, KB(bq), (j)); \
    finishSM(pA0, pA1, alA, l_reg, pa0, pa1, pa2, pa3); SBAR(); \
    pv_d0(o, VB(bp), pa0, pa1, pa2, pa3); partialSM<true>(pB0, pB1, m_reg, alB); \
    RESC(alB); DWAIT(); __syncthreads(); \
    bp = bq; bq = bw; bw = (bw == NBUF - 1) ? 0 : bw + 1; \
    DMA(bw, (j) + 2);                                             \
    SBAR(); QKY(pA0, pA1, KB(bq), (j) + 1); \
    finishSM(pB0, pB1, alB, l_reg, pa0, pa1, pa2, pa3); SBAR(); \
    pv_d0(o, VB(bp), pa0, pa1, pa2, pa3); partialSM<true>(pA0, pA1, m_reg, alA); \
    RESC(alA); DWAIT(); __syncthreads(); \
    bp = bq; bq = bw; bw = (bw == NBUF - 1) ? 0 : bw + 1; } while (0)
  if constexpr (MODE == 0) {
    if (NT > 2) BODY(QK, QKM, 1);
    for (int j = 3; j + 1 < NT; j += 2) BODY(QKM, QKM, j);
  } else {
    for (int j = 1; j + 1 < NT; j += 2) BODY(QK, QK, j);
  }
#undef BODY
  SBAR(); QK(pB0, pB1, KB(bq), NT - 1);
  finishSM(pA0, pA1, alA, l_reg, pa0, pa1, pa2, pa3); SBAR();
  pv_d0(o, VB(bp), pa0, pa1, pa2, pa3); partialSM<true>(pB0, pB1, m_reg, alB);
  RESC(alB);
  finishSM(pB0, pB1, alB, l_reg, pa0, pa1, pa2, pa3); SBAR();
  pv_d0(o, VB(bq), pa0, pa1, pa2, pa3);
#undef KB
#undef VB
  if (wid >= 4) __builtin_amdgcn_s_setprio(0);
  if (hi == 0) li_l[r32] = l_reg;
  asm volatile("s_waitcnt lgkmcnt(0)" ::: "memory");
  float rli[16];
#pragma unroll
  for (int r = 0; r < 16; ++r) rli[r] = __builtin_amdgcn_rcpf(li_l[crow(r, hi)]);
  bf16* Ow = Ob + (size_t)(wq * 32) * ldo;
  if constexpr (MODE == 1) {
    __syncthreads();
    LAS char* T = lds + wid * TBYTES;
    ATT_STORE_TILE(T, o[d0][r] * rli[r]);
  } else {
    LAS float* X = (LAS float*)(lds + OFF_X) + wq * 4096;
    __syncthreads();
    if (map == 1) {
#pragma unroll
      for (int d0 = 0; d0 < 4; ++d0)
#pragma unroll
        for (int r = 0; r < 16; ++r) X[(d0 * 16 + r) * 64 + lane] = o[d0][r] * rli[r] * lam;
    }
    asm volatile("s_waitcnt lgkmcnt(0)" ::: "memory");
    __syncthreads();
    if (map == 0) {
      float ss[16];
#pragma unroll
      for (int r = 0; r < 16; ++r) ss[r] = 0.f;
#pragma unroll
      for (int d0 = 0; d0 < 4; ++d0)
#pragma unroll
        for (int r = 0; r < 16; ++r) { const float d = o[d0][r] * rli[r] - X[(d0 * 16 + r) * 64 + lane]; o[d0][r] = d; ss[r] += d * d; }
#pragma unroll
      for (int r = 0; r < 16; ++r) {
#pragma unroll
        for (int s = 1; s < 32; s <<= 1) ss[r] += __shfl_xor(ss[r], s);
        ss[r] = rsqrtf(ss[r] * (1.0f / 128.0f) + EPS) * osc; }
      float g[4];
#pragma unroll
      for (int d0 = 0; d0 < 4; ++d0) g[d0] = gvec[d0 * 32 + r32];
      LAS char* T = (LAS char*)X;
      ATT_STORE_TILE(T, o[d0][r] * ss[r] * g[d0]);
    }
  }
#undef TILE_K0
#undef DQ
#undef CLS
#undef QK
#undef QKM
#undef DMA
#undef DWAIT
#undef RESC
}
}

constexpr size_t MiB = 1u << 20;
constexpr size_t WS_CTL = 0, CTL_ZERO_BYTES = MiB / 8;
constexpr size_t WS_ROWSS = 1 * MiB;
constexpr size_t WS_KVB = 4 * MiB;
constexpr size_t WS_WIN = 20 * MiB;
constexpr size_t WS_WOUT = 100 * MiB;
constexpr size_t WS_WUP = 132 * MiB;
constexpr size_t WS_WDN = 260 * MiB;
constexpr size_t WS_XB = 388 * MiB;
constexpr size_t WS_BIG = 516 * MiB;
constexpr size_t WS_HID = WS_BIG;
constexpr size_t WS_PROJ = WS_BIG;
constexpr size_t WS_MIX = WS_BIG + 320 * MiB;
constexpr size_t WS_WKV = WS_BIG + 448 * MiB;
constexpr size_t WS_KVRAW = WS_BIG + 464 * MiB;
constexpr size_t WS_MEMB = WS_BIG + 496 * MiB;
constexpr size_t WS_END = WS_BIG + 512 * MiB;
static_assert((size_t)2 * MCH * DFF * 2 <= 320 * MiB, "two hidden chunks fit below MIX in the BIG region");
constexpr int CW_QUEUE = 16384;
constexpr int CW_BAR = 4096;
constexpr int LDS_BYTES = 163840;
constexpr int LDS_SCR = 131072;
constexpr int LDS_MISC = LDS_BYTES - 512;
constexpr int LDS_PTRS = LDS_BYTES - 256;
static_assert(att::ATT_LDS <= LDS_MISC && LDS_SCR + 4096 <= LDS_MISC && 64 * 516 * 4 <= LDS_MISC, "LDS map");

__device__ __forceinline__ void cvt_w_tile(const float* __restrict__ W, int K, int N, const float* __restrict__ g, bf16* __restrict__ WT, int kb, int nb, LAS float* scr, int tid, bool mapf) {
    const int k0 = kb * 64, n0 = nb * 512;
    { const int c4 = (tid & 127) * 4; f32x4 w[16]; float gg[16];
#pragma unroll
      for (int it = 0; it < 16; ++it) { const int kk = it * 4 + (tid >> 7); w[it] = *(const GAS f32x4*)(W + (size_t)(k0 + kk) * N + n0 + c4); gg[it] = g ? g[k0 + kk] : 1.f; }
#pragma unroll
      for (int it = 0; it < 16; ++it) { const int kk = it * 4 + (tid >> 7); *(LAS f32x4*)(scr + kk * 516 + c4) = w[it] * gg[it]; } }
    __syncthreads();
    const int s = tid & 255, pl = tid >> 8, col = pl * 256 + pg8::slot_col(s, mapf);
    bf16* dst = WT + (size_t)(n0 + pl * 256 + s) * K + k0;
#pragma unroll
    for (int c = 0; c < 8; ++c) { float f[8];
#pragma unroll
        for (int j = 0; j < 8; ++j) f[j] = scr[(8 * c + j) * 516 + col];
        *(GAS bf16x8*)(dst + 8 * c) = pack8(f); }
    __syncthreads();
}
__device__ __forceinline__ float row_to_bf16(const float* __restrict__ xrow, bf16* __restrict__ orow, bool normalise, int lane) {
    const GAS f32x4* xr = (const GAS f32x4*)xrow + lane;
    f32x4 v[8]; float s = 0.f;
#pragma unroll
    for (int j = 0; j < 8; ++j) { v[j] = xr[64 * j]; s += (v[j].x * v[j].x + v[j].y * v[j].y) + (v[j].z * v[j].z + v[j].w * v[j].w); }
    s = wave_sum(s);
    const float sc = normalise ? rsqrtf(s * (1.0f / DM) + EPS) : 1.f;
    const bool odd = (lane & 1) != 0;
#pragma unroll
    for (int j = 0; j < 8; j += 2) {
        const unsigned a0 = pg8::cvt_pk_bf16(v[j].x * sc, v[j].y * sc), a1 = pg8::cvt_pk_bf16(v[j].z * sc, v[j].w * sc);
        const unsigned b0 = pg8::cvt_pk_bf16(v[j + 1].x * sc, v[j + 1].y * sc), b1 = pg8::cvt_pk_bf16(v[j + 1].z * sc, v[j + 1].w * sc);
        const unsigned s0 = odd ? a0 : b0, s1 = odd ? a1 : b1;
        const unsigned r0 = (unsigned)__builtin_amdgcn_mov_dpp((int)s0, 0xB1, 0xF, 0xF, true), r1 = (unsigned)__builtin_amdgcn_mov_dpp((int)s1, 0xB1, 0xF, 0xF, true);
        const v4u w = odd ? (v4u){r0, r1, b0, b1} : (v4u){a0, a1, r0, r1};
        *(GAS v4u*)(orow + (odd ? 256 * (j + 1) + 4 * (lane - 1) : 256 * j + 4 * lane)) = w;
    }
    return s;
}
__device__ __forceinline__ void kv_row(const float* __restrict__ src, bf16* __restrict__ dst, const float* __restrict__ gk, int lane) {
    const f32x4 a = *(const GAS f32x4*)(src + 8 * lane), b = *(const GAS f32x4*)(src + 8 * lane + 4);
    float ss = (a.x * a.x + a.y * a.y) + (a.z * a.z + a.w * a.w) + (b.x * b.x + b.y * b.y) + (b.z * b.z + b.w * b.w);
    ss += __shfl_xor(ss, 1); ss += __shfl_xor(ss, 2); ss += __shfl_xor(ss, 4); ss += __shfl_xor(ss, 8);
    const float rn = rsqrtf(ss * (1.0f / 128.0f) + EPS);
    const float* gp = gk + ((8 * lane) & 127);
    float f[8] = {a.x * rn * gp[0], a.y * rn * gp[1], a.z * rn * gp[2], a.w * rn * gp[3], b.x * rn * gp[4], b.y * rn * gp[5], b.z * rn * gp[6], b.w * rn * gp[7]};
    *(GAS bf16x8*)(dst + 8 * lane) = pack8(f);
    const f32x4 c = *(const GAS f32x4*)(src + 512 + 8 * lane), d = *(const GAS f32x4*)(src + 512 + 8 * lane + 4);
    float h[8] = {c.x, c.y, c.z, c.w, d.x, d.y, d.z, d.w};
    *(GAS bf16x8*)(dst + 512 + 8 * lane) = pack8(h);
}
__device__ __forceinline__ void load_gcu(const bf16* __restrict__ P, int row, int c0, float (&v)[8]) {
    const bf16x8 gc = *(const GAS bf16x8*)(P + (size_t)row * NIN + 3584 + c0), uu = *(const GAS bf16x8*)(P + (size_t)row * NIN + 4096 + c0);
#pragma unroll
    for (int i = 0; i < 8; ++i) v[i] = bf2f(gc[i]) * bf2f(uu[i]);
}
__device__ __forceinline__ void conv_rows16(const bf16* __restrict__ P, bf16* __restrict__ MIX, const float* __restrict__ cw, const float* __restrict__ gco, int row0, int lane) {
    const int c0 = lane * 8;
    float w0[8], w1[8], w2[8], g[8];
#pragma unroll
    for (int i = 0; i < 8; ++i) { w0[i] = cw[c0 + i]; w1[i] = cw[512 + c0 + i]; w2[i] = cw[1024 + c0 + i]; g[i] = gco[c0 + i]; }
    float vp[8], vc[8];
    if ((row0 & (SEQ - 1)) != 0) load_gcu(P, row0 - 1, c0, vp); else {
#pragma unroll
        for (int i = 0; i < 8; ++i) vp[i] = 0.f; }
    load_gcu(P, row0, c0, vc);
    bf16x8 gcn[2][4], un[2][4], gb[2][4];
#define CONV_LOAD(B, rb_) do { _Pragma("unroll") for (int k = 0; k < 4; ++k) { const int row = row0 + (rb_) + k; const int rn = ((row & (SEQ - 1)) != SEQ - 1) ? row + 1 : row;     \
            gcn[B][k] = *(const GAS bf16x8*)(P + (size_t)rn * NIN + 3584 + c0); un[B][k] = *(const GAS bf16x8*)(P + (size_t)rn * NIN + 4096 + c0); \
            gb[B][k] = *(const GAS bf16x8*)(P + (size_t)row * NIN + 3072 + c0); } } while (0)
#define CONV_WORK(B, rb_) do { _Pragma("unroll") for (int k = 0; k < 4; ++k) { const int row = row0 + (rb_) + k; const bool has_n = (row & (SEQ - 1)) != SEQ - 1; \
            float vn[8], c[8]; float ss = 0.f; \
            _Pragma("unroll") for (int i = 0; i < 8; ++i) { vn[i] = has_n ? bf2f(gcn[B][k][i]) * bf2f(un[B][k][i]) : 0.f; \
                const float y = w0[i] * vp[i] + w1[i] * vc[i] + w2[i] * vn[i]; c[i] = bf2f(gb[B][k][i]) * y; ss += c[i] * c[i]; } \
            ss += __shfl_xor(ss, 1); ss += __shfl_xor(ss, 2); ss += __shfl_xor(ss, 4); ss += __shfl_xor(ss, 8); \
            const float rn = rsqrtf(ss * (1.0f / 128.0f) + EPS); \
            _Pragma("unroll") for (int i = 0; i < 8; ++i) { c[i] = c[i] * rn * g[i]; vp[i] = vc[i]; vc[i] = vn[i]; } \
            *(GAS bf16x8*)(MIX + (size_t)row * DM + 1024 + c0) = pack8(c); } } while (0)
    CONV_LOAD(0, 0);
    CONV_LOAD(1, 4);  asm volatile("" ::: "memory"); CONV_WORK(0, 0);
    CONV_LOAD(0, 8);  asm volatile("" ::: "memory"); CONV_WORK(1, 4);
    CONV_LOAD(1, 12); asm volatile("" ::: "memory"); CONV_WORK(0, 8);
    CONV_WORK(1, 12);
#undef CONV_LOAD
#undef CONV_WORK
}

template <class T> __device__ __forceinline__ GAS T* opq(T* p) { GAS T* q = (GAS T*)p; asm volatile("" : "+s"(q)); return q; }
__device__ __forceinline__ const float* in_ptr(LAS unsigned char* lds, int i) {
    unsigned off = LDS_PTRS + 8 * i; asm volatile("" : "+v"(off));
    const unsigned lo = *(volatile LAS unsigned*)(lds + off), hi = *(volatile LAS unsigned*)(lds + off + 4);
    return (const float*)(const GAS float*)(uintptr_t)(((unsigned long long)(unsigned)__builtin_amdgcn_readfirstlane((int)hi) << 32) | (unsigned)__builtin_amdgcn_readfirstlane((int)lo));
}
struct Args { const float* in[21]; float* out; unsigned char* ws; int ph_lo, ph_hi; };
constexpr int PH_PER_LAYER = 4 + NCH, N_PHASES = 2 + DEPTH * PH_PER_LAYER;
__global__ void __launch_bounds__(512, 2) hybrid_fwd(Args args) {
    extern __shared__ __attribute__((aligned(16))) unsigned char lds_raw[];
    LAS unsigned char* lds = (LAS unsigned char*)lds_raw;
    volatile LAS unsigned* MISC = (volatile LAS unsigned*)(lds + LDS_MISC);
    const int tid0 = threadIdx.x, wave = __builtin_amdgcn_readfirstlane(tid0 >> 6);
    const int G = gridDim.x; const int bx = blockIdx.x; const int vcu = (G % 8 == 0) ? (bx % 8) * (G / 8) + bx / 8 : bx;
    unsigned char* ws0 = args.ws;
    if (tid0 < 64) MISC[tid0] = 0u;
    if (tid0 == 0) { LAS unsigned long long* pt = (LAS unsigned long long*)(lds + LDS_PTRS);
#define PUT(i) pt[i] = (unsigned long long)(uintptr_t)args.in[i]
        PUT(0); PUT(1); PUT(2); PUT(3); PUT(4); PUT(5); PUT(6); PUT(7); PUT(8); PUT(9); PUT(10); PUT(11); PUT(12); PUT(13); PUT(14); PUT(15); PUT(16); PUT(17); PUT(18); PUT(19); PUT(20);
#undef PUT
    }
    __syncthreads();
    XcdBarrier bar = xcd_barrier_post((unsigned*)(ws0 + WS_CTL) + CW_BAR, MISC + 8);
    float* out0 = args.out;
#define INP(i) in_ptr(lds, (i))
#define rowss ((float*)(GAS float*)(ws + WS_ROWSS))
#define KVB ((bf16*)(GAS bf16*)(ws + WS_KVB))
#define WIN ((bf16*)(GAS bf16*)(ws + WS_WIN))
#define WKV ((bf16*)(GAS bf16*)(ws + WS_WKV))
#define WOUT ((bf16*)(GAS bf16*)(ws + WS_WOUT))
#define WUP ((bf16*)(GAS bf16*)(ws + WS_WUP))
#define WDN ((bf16*)(GAS bf16*)(ws + WS_WDN))
#define XB ((bf16*)(GAS bf16*)(ws + WS_XB))
#define MIX ((bf16*)(GAS bf16*)(ws + WS_MIX))
#define KVRAW ((float*)(GAS float*)(ws + WS_KVRAW))
#define MEMB ((bf16*)(GAS bf16*)(ws + WS_MEMB))
#define PROJ ((bf16*)(GAS bf16*)(ws + WS_PROJ))
#define HID ((bf16*)(GAS bf16*)(ws + WS_HID))
    const int lo = args.ph_lo, hi = args.ph_hi;
#define IN(k) (lo <= (k) && (k) < hi)
#define SEAM(k) do { if (IN((k) + 1)) xcd_barrier(bar); } while (0)
    const int gw = vcu * 8 + wave, NGW = G * 8;

    if (IN(0)) {
            GAS unsigned char* ws = opq(ws0); float* out = (float*)opq(out0); (void)out; int tid = tid0; asm volatile("" : "+v"(tid)); const int lane = tid & 63; (void)lane;
        LAS float* scr = (LAS float*)lds;
        constexpr int T_IN = 32 * 10, T_KV = 32 * 2, T_OUT = 32 * 4, T_UP = 32 * 16, T_DN = 128 * 4, T_LAYER = T_IN + T_KV + T_OUT + T_UP + T_DN;
        for (int t = vcu; t < DEPTH * T_LAYER; t += G) {
            const int l = t / T_LAYER; int r = t % T_LAYER;
            if (r < T_IN) { cvt_w_tile(INP(3) + (size_t)l * DM * NIN, DM, NIN, INP(2) + l * DM, WIN + (size_t)l * NIN * DM, r / 10, r % 10, scr, tid, false); continue; } r -= T_IN;
            if (r < T_KV) { cvt_w_tile(INP(14) + (size_t)l * DM * NKV, DM, NKV, INP(13) + l * DM, WKV + (size_t)l * NKV * DM, r / 2, r % 2, scr, tid, true); continue; } r -= T_KV;
            if (r < T_OUT) { cvt_w_tile(INP(17) + (size_t)l * DM * DM, DM, DM, nullptr, WOUT + (size_t)l * DM * DM, r / 4, r % 4, scr, tid, false); continue; } r -= T_OUT;
            if (r < T_UP) { cvt_w_tile(INP(19) + (size_t)l * DM * DFF, DM, DFF, INP(18) + l * DM, WUP + (size_t)l * DFF * DM, r / 16, r % 16, scr, tid, false); continue; } r -= T_UP;
            cvt_w_tile(INP(20) + (size_t)l * DFF * DM, DFF, DM, nullptr, WDN + (size_t)l * DM * DFF, r / 4, r % 4, scr, tid, false);
        }
        for (int m = gw; m < MTOT; m += NGW) {
            const float s = row_to_bf16(INP(0) + (size_t)m * DM, XB + (size_t)m * DM, false, lane);
            if (lane < 8) rowss[(size_t)lane * MTOT + m] = lane == 0 ? s : 0.f;
        }
        for (int m = gw; m < MROWS; m += NGW) (void)row_to_bf16(INP(1) + (size_t)m * DM, MEMB + (size_t)m * DM, true, lane);
        SEAM(0);
    }
    if (IN(1)) {
            GAS unsigned char* ws = opq(ws0); float* out = (float*)opq(out0); (void)out; int tid = tid0; asm volatile("" : "+v"(tid)); const int lane = tid & 63; (void)lane;
        pg8::Gemm g{MEMB, WKV, MROWS, DEPTH * NKV, DM}; pg8::StaticOrder S; S.init(MROWS, DEPTH * NKV, G, bx);
        pg8::EpiF32 E{KVRAW, DEPTH * NKV};
        pg8::gemm_phase<pg8::EpiF32, pg8::StaticOrder, true, true>(lds, g, S, E);
        SEAM(1);
    }
    for (int l = 0; l < DEPTH; ++l) {
        const int pb = 2 + l * PH_PER_LAYER;
        if (IN(pb)) {
            GAS unsigned char* ws = opq(ws0); float* out = (float*)opq(out0); (void)out; int tid = tid0; asm volatile("" : "+v"(tid)); const int lane = tid & 63; (void)lane;
            if (l == 0) {
                for (int it = gw; it < DEPTH * MROWS; it += NGW) { const int ll = it / MROWS, row = it % MROWS;
                    kv_row(KVRAW + (size_t)row * (DEPTH * NKV) + ll * NKV, KVB + ((size_t)ll * MROWS + row) * NKV, INP(16) + ll * 128, lane); }
            }
            pg8::Gemm g{XB, WIN + (size_t)l * NIN * DM, MTOT, NIN, DM}; pg8::StaticOrder S; S.init(MTOT, NIN, G, bx);
            pg8::EpiA E{PROJ, rowss, INP(4) + l * 64, INP(5) + l * 64};
            pg8::gemm_phase<pg8::EpiA, pg8::StaticOrder, true, true>(lds, g, S, E);
            SEAM(pb);
        }
        if (IN(pb + 1)) {
            GAS unsigned char* ws = opq(ws0); float* out = (float*)opq(out0); (void)out; int tid = tid0; asm volatile("" : "+v"(tid)); const int lane = tid & 63; (void)lane;
            float lam, osc;
            { float a = INP(6)[l * 64 + lane] * INP(7)[l * 64 + lane], b = INP(8)[l * 64 + lane] * INP(9)[l * 64 + lane];
              a = wave_sum(a); b = wave_sum(b); const float li = 0.8f - 0.6f * expf(-0.3f * (float)l); lam = expf(a) - expf(b) + li; osc = 1.f - li;
              lam = __uint_as_float(__builtin_amdgcn_readfirstlane(__float_as_uint(lam))); osc = __uint_as_float(__builtin_amdgcn_readfirstlane(__float_as_uint(osc))); }
            for (int ch = gw; ch < MTOT / 16; ch += NGW) conv_rows16(PROJ, MIX, INP(11) + l * 1536, INP(12) + l * 512, ch * 16, lane);
            float smaxm;
            { const float* gq = INP(15) + l * 128; const float* gk = INP(16) + l * 128;
              float ma = fmaxf(fabsf(gq[lane]), fabsf(gq[64 + lane])), mb = fmaxf(fabsf(gk[lane]), fabsf(gk[64 + lane]));
#pragma unroll
              for (int o = 1; o < 64; o <<= 1) { ma = fmaxf(ma, __shfl_xor(ma, o)); mb = fmaxf(mb, __shfl_xor(mb, o)); }
              smaxm = 128.f * QSCALE_M * ma * mb * 1.02f;
              smaxm = __uint_as_float(__builtin_amdgcn_readfirstlane(__float_as_uint(smaxm))); }
            for (int k = vcu; k < BATCH * 4 * (SEQ / 256); k += G) { const int bhm = k >> 4, qt = k & 15, b = bhm >> 2, hm = bhm & 3;
                const size_t r0 = (size_t)b * SEQ + qt * 256; const bf16* kv = KVB + ((size_t)l * MROWS + b * MEMTOK) * NKV + hm * 128;
                att::attn_unit<1>((LAS char*)lds, PROJ + r0 * NIN + 4608 + hm * 128, NIN, kv, kv + 512, NKV, MEMTOK / 64, 0, 0, 0.f, 0,
                                  MIX + r0 * DM + 1536 + hm * 128, DM, INP(15) + l * 128, 0.f, 1.f, smaxm); }
            float smax2;
            { const float a = fabsf(INP(4)[l * 64 + lane]), b = fabsf(INP(5)[l * 64 + lane]); float ma = a, mb = b;
#pragma unroll
              for (int o = 1; o < 64; o <<= 1) { ma = fmaxf(ma, __shfl_xor(ma, o)); mb = fmaxf(mb, __shfl_xor(mb, o)); }
              smax2 = 64.f * QSCALE_D * ma * mb * 1.02f;
              smax2 = __uint_as_float(__builtin_amdgcn_readfirstlane(__float_as_uint(smax2))); }
            {
            gu32* qbase = (gu32*)(GAS unsigned*)(ws + WS_CTL) + CW_QUEUE + l * 8 * 64;
            volatile LAS unsigned* slot = (volatile LAS unsigned*)(lds + LDS_MISC) + 16;
            for (int qq = 0; qq < 8; ++qq) { const int q = (bx + qq) & 7;
                for (;;) {
                    __syncthreads();
                    if (tid == 0) slot[0] = __hip_atomic_fetch_add(qbase + q * 64, 1u, RLX_AGENT);
                    __syncthreads();
                    const unsigned idx = slot[0];
                    if (idx >= 8u * (SEQ / 128)) break;
                    const int b = q, h = 7 - (int)(idx >> 5), qt = (int)(idx & 31);
                    const float mh2 = exp2f(-(float)(h + 1)) * LOG2E;
                    const float d0f = ceilf((25.f + 2.f * smax2) / mh2);
                    const int d0 = d0f < 8192.f ? (int)d0f : 8192;
                    int tlo = (qt * 128 - d0) >> 6, thi = (qt * 128 + 127 + d0) >> 6;
                    tlo = tlo < 0 ? 0 : tlo; thi = thi > SEQ / 64 - 1 ? SEQ / 64 - 1 : thi;
                    if (((thi - tlo + 1) & 1) != 0) { if (tlo > 0) --tlo; else ++thi; }
                    const size_t r0 = (size_t)b * SEQ + qt * 128; const bf16* kb = PROJ + (size_t)b * SEQ * NIN + 1024 + h * 128;
                    att::attn_unit<0>((LAS char*)lds, PROJ + r0 * NIN + h * 128, NIN, kb, kb + 1024, NIN, thi - tlo + 1, qt * 2 - tlo, tlo, mh2, qt * 128,
                                      MIX + r0 * DM + h * 128, DM, INP(10) + l * 128, lam, osc, smax2);
                }
            }
            }
            SEAM(pb + 1);
        }
        if (IN(pb + 2)) {
            GAS unsigned char* ws = opq(ws0); float* out = (float*)opq(out0); (void)out; int tid = tid0; asm volatile("" : "+v"(tid)); const int lane = tid & 63; (void)lane;
            pg8::Gemm g{MIX, WOUT + (size_t)l * DM * DM, MTOT, DM, DM}; pg8::StaticOrder S; S.init(MTOT, DM, G, bx);
            if (l == 0) { pg8::EpiResB<true> E{XB, INP(0), out, rowss, 0, (LAS float*)(lds + LDS_SCR), 0};
                pg8::gemm_phase<pg8::EpiResB<true>, pg8::StaticOrder, true, true>(lds, g, S, E); }
            else { pg8::EpiResB<false> E{XB, INP(0), out, rowss, 0, (LAS float*)(lds + LDS_SCR), 0};
                pg8::gemm_phase<pg8::EpiResB<false>, pg8::StaticOrder, true, true>(lds, g, S, E); }
            SEAM(pb + 2);
        }
        for (int c = 0; c <= NCH; ++c) {
            if (IN(pb + 3 + c)) {
            GAS unsigned char* ws = opq(ws0); float* out = (float*)opq(out0); (void)out; int tid = tid0; asm volatile("" : "+v"(tid)); const int lane = tid & 63; (void)lane;
                if (c > 0) { const int m0 = (c - 1) * MCH;
                    pg8::Gemm g{HID + (size_t)((c - 1) & 1) * MCH * DFF, WDN + (size_t)l * DM * DFF, MCH, DM, DFF}; pg8::StaticOrder S; S.init(MCH, DM, G, bx);
                    pg8::EpiResB<false> E{XB, INP(0), out, rowss, m0, (LAS float*)(lds + LDS_SCR), l == DEPTH - 1};
                    pg8::gemm_phase<pg8::EpiResB<false>, pg8::StaticOrder, true, true>(lds, g, S, E); }
                if (c < NCH) { const int m0 = c * MCH;
                    pg8::Gemm g{XB + (size_t)m0 * DM, WUP + (size_t)l * DFF * DM, MCH, DFF, DM}; pg8::StaticOrder S; S.init(MCH, DFF, G, bx);
                    pg8::EpiRelu2 E{HID + (size_t)(c & 1) * MCH * DFF, rowss, m0};
                    pg8::gemm_phase<pg8::EpiRelu2, pg8::StaticOrder, true, true>(lds, g, S, E); }
                SEAM(pb + 3 + c);
            }
        }
    }
#undef IN
#undef SEAM
#undef INP
#undef rowss
#undef KVB
#undef WIN
#undef WKV
#undef WOUT
#undef WUP
#undef WDN
#undef XB
#undef MIX
#undef KVRAW
#undef MEMB
#undef PROJ
#undef HID
}

#ifndef N_LAUNCHES
#define N_LAUNCHES 1
#endif
extern "C" void kernel_launch(void* const* d_in, const int* in_sizes, int n_in, void* d_out, int out_size, void* d_ws, size_t ws_size, hipStream_t stream) {
    static int grid = 0;
    if (grid == 0) {
        if (n_in != 21 || in_sizes[0] != MTOT * DM || out_size != MTOT * DM || ws_size < WS_END) {
            fprintf(stderr, "kernel_launch: shape/workspace mismatch: n_in %d in0 %d out %d ws %zu (need %zu)\n", n_in, n_in > 0 ? in_sizes[0] : -1, out_size, ws_size, (size_t)WS_END); grid = -1; return; }
        int dev = 0, cus = 0, per_cu = 0;
        if (hipGetDevice(&dev) != hipSuccess || hipDeviceGetAttribute(&cus, hipDeviceAttributeMultiprocessorCount, dev) != hipSuccess) { grid = -1; return; }
        if (hipFuncSetAttribute((const void*)hybrid_fwd, hipFuncAttributeMaxDynamicSharedMemorySize, LDS_BYTES) != hipSuccess) { fprintf(stderr, "kernel_launch: hipFuncSetAttribute failed\n"); grid = -1; return; }
        if (hipOccupancyMaxActiveBlocksPerMultiprocessor(&per_cu, (const void*)hybrid_fwd, 512, LDS_BYTES) != hipSuccess || per_cu < 1)
            fprintf(stderr, "kernel_launch: note: occupancy query reports %d workgroups per CU\n", per_cu);
        (void)hipGetLastError();
        grid = cus;
    }
    if (grid < 0) return;
    Args a{};
    for (int i = 0; i < 21; ++i) a.in[i] = (const float*)d_in[i];
    a.out = (float*)d_out; a.ws = (unsigned char*)d_ws;
#if N_LAUNCHES == 1
    if (hipMemsetAsync((char*)d_ws + WS_CTL, 0, CTL_ZERO_BYTES, stream) != hipSuccess) return;
    a.ph_lo = 0; a.ph_hi = N_PHASES;
    hipLaunchKernelGGL(hybrid_fwd, dim3(grid), dim3(512), LDS_BYTES, stream, a);
#else
    for (int p = 0; p < N_PHASES; ++p) {
        if (hipMemsetAsync((char*)d_ws + WS_CTL, 0, CTL_ZERO_BYTES, stream) != hipSuccess) return;
        a.ph_lo = p; a.ph_hi = p + 1;
        hipLaunchKernelGGL(hybrid_fwd, dim3(grid), dim3(512), LDS_BYTES, stream, a);
    }
#endif
    const hipError_t le = hipPeekAtLastError();
    if (le != hipSuccess) fprintf(stderr, "kernel_launch: launch failed: %s\n", hipGetErrorName(le));
}
```
